# Optimizing an MI355X kernel written in HIP

```python
import jax, jax.numpy as jnp
from jax import lax
import numpy as np

D_MODEL = 2048
BATCH = 1
SEQ = 16384
DEPTH = 4

MIX = D_MODEL
HALF = MIX // 2
HEAD_DIM = 128
N_HEADS = HALF // HEAD_DIM
POOL_WINDOWS = (2, 4, 8, 16)
POOL_GROUPS = len(POOL_WINDOWS)
POOL_GW = HALF // POOL_GROUPS
MOBA_BLOCK = 256
MOBA_TOPK = 3
MOBA_Q_CHUNK = 64
DSA_TOPK_MAX = 256
DSA_IDX_HEADS = 8
DSA_IDX_DIM = 64
DSA_Q_CHUNK = 128
CONV_WIDTH = 31
N_EVEN = (DEPTH + 1) // 2
N_ODD = DEPTH // 2
EVEN_WIDTHS = (HALF, HALF, HALF, HALF, MIX)
EVEN_IN = 4 * HALF + MIX
ODD_WIDTHS = (HALF, HALF, HALF, DSA_IDX_HEADS * DSA_IDX_DIM, DSA_IDX_HEADS, DSA_IDX_DIM, HALF, HALF, MIX)
ODD_IN = 5 * HALF + DSA_IDX_HEADS * DSA_IDX_DIM + DSA_IDX_HEADS + DSA_IDX_DIM + MIX
EPS = 1e-6
NEG_INF = -1e30

kernel_name = 'hybrid_pool_moba_dsa_conformer_trunk'


def _offsets(widths):
    out, s = [], 0
    for w in widths[:-1]:
        s += w
        out.append(s)
    return out


def _rms(x, g):
    x32 = x.astype(jnp.float32)
    y = x32 * lax.rsqrt(jnp.mean(x32 * x32, axis=-1, keepdims=True) + EPS)
    return (y * g.astype(jnp.float32)).astype(x.dtype)


def _alibi_slopes(n):
    return jnp.exp2(-8.0 * jnp.arange(1, n + 1, dtype=jnp.float32) / n)


def _pool_mixer(u, pool_w, pool_scale):
    S = u.shape[1]
    u32 = u.astype(jnp.float32)
    cs = jnp.cumsum(u32, axis=1)
    t1 = jnp.arange(1, S + 1, dtype=jnp.float32)[None, :, None]
    outs = []
    for g, w in enumerate(POOL_WINDOWS):
        sl = slice(g * POOL_GW, (g + 1) * POOL_GW)
        csg = cs[:, :, sl]
        prev = jnp.pad(csg, ((0, 0), (w, 0), (0, 0)))[:, :S]
        mean = (csg - prev) / jnp.minimum(t1, float(w))
        outs.append(mean - u32[:, :, sl])
    d = jnp.stack(outs, axis=2).astype(u.dtype)
    y = jnp.einsum('bsgc,gcd->bsgd', d, pool_w).reshape(u.shape)
    return y * pool_scale


def _moba_attention(q, k, v):
    B_, S, H, Dh = q.shape
    nb = -(-S // MOBA_BLOCK)
    s_pad = nb * MOBA_BLOCK
    pad = ((0, 0), (0, s_pad - S), (0, 0), (0, 0))
    kb = jnp.pad(k, pad).reshape(B_, nb, MOBA_BLOCK, H, Dh).transpose(0, 3, 1, 2, 4)
    vb = jnp.pad(v, pad).reshape(B_, nb, MOBA_BLOCK, H, Dh).transpose(0, 3, 1, 2, 4)
    kmean = jnp.mean(kb.astype(jnp.float32), axis=3)
    n_sel = max(1, min(MOBA_TOPK, nb - 1))
    slopes = _alibi_slopes(H)[None, :, None, None]
    scale = Dh ** -0.5
    bi = jnp.arange(B_)[:, None, None, None]
    hi = jnp.arange(H)[None, :, None, None]
    blk_ids = jnp.arange(nb)
    in_blk = jnp.arange(MOBA_BLOCK)
    rank = jnp.arange(n_sel)

    def chunk(ci):
        t0 = ci * MOBA_Q_CHUNK
        tq = t0 + jnp.arange(MOBA_Q_CHUNK)
        qc = lax.dynamic_slice_in_dim(q, t0, MOBA_Q_CHUNK, axis=1).transpose(0, 2, 1, 3)
        qc32 = qc.astype(jnp.float32)
        own = t0 // MOBA_BLOCK
        k_own = lax.dynamic_index_in_dim(kb, own, axis=2, keepdims=False)
        v_own = lax.dynamic_index_in_dim(vb, own, axis=2, keepdims=False)
        dist_own = (tq[:, None] - (own * MOBA_BLOCK + in_blk)[None, :]).astype(jnp.float32)
        s_own = jnp.einsum('bhqd,bhkd->bhqk', qc32, k_own.astype(jnp.float32)) * scale - slopes * dist_own
        s_own = jnp.where(dist_own >= 0, s_own, NEG_INF)
        gsc = jnp.einsum('bhqd,bhnd->bhqn', qc32, kmean)
        gsc = jnp.where(blk_ids < own, gsc, NEG_INF)
        _, idx = lax.top_k(gsc, n_sel)
        valid = rank < own
        k_sel = kb[bi, hi, idx]
        v_sel = vb[bi, hi, idx]
        pos_sel = idx[..., None] * MOBA_BLOCK + in_blk
        dist_sel = (tq[None, None, :, None, None] - pos_sel).astype(jnp.float32)
        s_sel = jnp.einsum('bhqd,bhqrkd->bhqrk', qc32, k_sel.astype(jnp.float32)) * scale - slopes[..., None] * dist_sel
        s_sel = jnp.where(valid[:, None], s_sel, NEG_INF).reshape(B_, H, MOBA_Q_CHUNK, n_sel * MOBA_BLOCK)
        p = jax.nn.softmax(jnp.concatenate([s_own, s_sel], axis=-1), axis=-1)
        p_own = p[..., :MOBA_BLOCK]
        p_sel = p[..., MOBA_BLOCK:].reshape(B_, H, MOBA_Q_CHUNK, n_sel, MOBA_BLOCK)
        o = (jnp.einsum('bhqk,bhkd->bhqd', p_own, v_own.astype(jnp.float32))
             + jnp.einsum('bhqrk,bhqrkd->bhqd', p_sel, v_sel.astype(jnp.float32)))
        return o.astype(q.dtype).transpose(0, 2, 1, 3)

    out = lax.map(chunk, jnp.arange(S // MOBA_Q_CHUNK))
    return out.transpose(1, 0, 2, 3, 4).reshape(B_, S, H * Dh)


def _dsa_attention(q, k, v, qi, wi, ki):
    B_, S, H, Dh = q.shape
    n_sel = min(DSA_TOPK_MAX, S // 4)
    slopes = _alibi_slopes(H)[None, :, None, None]
    scale = Dh ** -0.5
    idx_scale = DSA_IDX_DIM ** -0.5
    bi = jnp.arange(B_)[:, None, None]
    pos = jnp.arange(S)

    def chunk(ci):
        t0 = ci * DSA_Q_CHUNK
        tq = t0 + jnp.arange(DSA_Q_CHUNK)
        qic = lax.dynamic_slice_in_dim(qi, t0, DSA_Q_CHUNK, axis=1).astype(jnp.float32)
        wic = lax.dynamic_slice_in_dim(wi, t0, DSA_Q_CHUNK, axis=1).astype(jnp.float32)
        logits = jax.nn.relu(jnp.einsum('bqhd,bsd->bqhs', qic, ki.astype(jnp.float32)) * idx_scale)
        score = jnp.einsum('bqh,bqhs->bqs', wic, logits)
        score = jnp.where(pos[None, None, :] <= tq[None, :, None], score, NEG_INF)
        _, idx = lax.top_k(score, n_sel)
        valid = idx <= tq[None, :, None]
        k_sel = k[bi, idx]
        v_sel = v[bi, idx]
        qc = lax.dynamic_slice_in_dim(q, t0, DSA_Q_CHUNK, axis=1).astype(jnp.float32)
        s = jnp.einsum('bqhd,bqkhd->bhqk', qc, k_sel.astype(jnp.float32)) * scale
        dist = (tq[None, :, None] - idx).astype(jnp.float32)[:, None]
        s = jnp.where(valid[:, None], s - slopes * dist, NEG_INF)
        p = jax.nn.softmax(s, axis=-1)
        o = jnp.einsum('bhqk,bqkhd->bqhd', p, v_sel.astype(jnp.float32))
        return o.astype(q.dtype)

    out = lax.map(chunk, jnp.arange(S // DSA_Q_CHUNK))
    return out.transpose(1, 0, 2, 3, 4).reshape(B_, S, H * Dh)


def _conv_module(a, b, conv_w, conv_b, ln_g, ln_b):
    u = a * jax.nn.sigmoid(b)
    y = lax.conv_general_dilated(u, conv_w[:, None, :].astype(u.dtype), window_strides=(1,),
                                 padding=[(CONV_WIDTH - 1, 0)],
                                 dimension_numbers=('NWC', 'WIO', 'NWC'),
                                 feature_group_count=HALF)
    y32 = (y + conv_b).astype(jnp.float32)
    mu = jnp.mean(y32, axis=-1, keepdims=True)
    var = jnp.mean(jnp.square(y32 - mu), axis=-1, keepdims=True)
    y32 = (y32 - mu) * lax.rsqrt(var + EPS) * ln_g.astype(jnp.float32) + ln_b.astype(jnp.float32)
    return jax.nn.silu(y32).astype(a.dtype)


def setup_inputs(seed: int = 0) -> dict:
    key = jax.random.key(seed)
    ks = jax.random.split(key, 18)
    f32 = jnp.float32

    def nrm(k, shape, s):
        return jax.random.normal(k, shape, f32) * s

    return {
        'x': nrm(ks[0], (BATCH, SEQ, D_MODEL), 1.0),
        'c': nrm(ks[1], (BATCH, D_MODEL), 1.0),
        'norm_g': 1.0 + nrm(ks[2], (DEPTH, D_MODEL), 0.02),
        'ada_w': nrm(ks[3], (DEPTH, D_MODEL, 3 * D_MODEL), 0.5 * D_MODEL ** -0.5),
        'ada_b': nrm(ks[4], (DEPTH, 3 * D_MODEL), 0.02),
        'w_out': nrm(ks[5], (DEPTH, MIX, D_MODEL), MIX ** -0.5),
        'ev_w_in': nrm(ks[6], (N_EVEN, D_MODEL, EVEN_IN), D_MODEL ** -0.5),
        'pool_w': nrm(ks[7], (N_EVEN, POOL_GROUPS, POOL_GW, POOL_GW), POOL_GW ** -0.5),
        'pool_scale': 1.0 + nrm(ks[8], (N_EVEN, HALF), 0.1),
        'moba_qn': 1.0 + nrm(ks[9], (N_EVEN, HEAD_DIM), 0.02),
        'moba_kn': 1.0 + nrm(ks[10], (N_EVEN, HEAD_DIM), 0.02),
        'od_w_in': nrm(ks[11], (N_ODD, D_MODEL, ODD_IN), D_MODEL ** -0.5),
        'dsa_qn': 1.0 + nrm(ks[12], (N_ODD, HEAD_DIM), 0.02),
        'dsa_kn': 1.0 + nrm(ks[13], (N_ODD, HEAD_DIM), 0.02),
        'conv_w': nrm(ks[14], (N_ODD, CONV_WIDTH, HALF), CONV_WIDTH ** -0.5),
        'conv_b': nrm(ks[15], (N_ODD, HALF), 0.02),
        'conv_ln_g': 1.0 + nrm(ks[16], (N_ODD, HALF), 0.02),
        'conv_ln_b': nrm(ks[17], (N_ODD, HALF), 0.02),
    }


def reference(x, c, norm_g, ada_w, ada_b, w_out, ev_w_in, pool_w, pool_scale, moba_qn, moba_kn,
              od_w_in, dsa_qn, dsa_kn, conv_w, conv_b, conv_ln_g, conv_ln_b):
    B_, S, _ = x.shape
    c_act = jax.nn.silu(c)
    for l in range(DEPTH):
        mod = c_act @ ada_w[l] + ada_b[l]
        shift, scl, gate_res = jnp.split(mod[:, None, :], 3, axis=-1)
        h = _rms(x, norm_g[l]) * (1.0 + scl) + shift
        if l % 2 == 0:
            e = l // 2
            z = h @ ev_w_in[e]
            u_a, q, k, v, g = jnp.split(z, _offsets(EVEN_WIDTHS), axis=-1)
            q = _rms(q.reshape(B_, S, N_HEADS, HEAD_DIM), moba_qn[e])
            k = _rms(k.reshape(B_, S, N_HEADS, HEAD_DIM), moba_kn[e])
            v = v.reshape(B_, S, N_HEADS, HEAD_DIM)
            y = jnp.concatenate([_pool_mixer(u_a, pool_w[e], pool_scale[e]),
                                 _moba_attention(q, k, v)], axis=-1)
        else:
            o = l // 2
            z = h @ od_w_in[o]
            q, k, v, qi, wi, ki, ga, gb, g = jnp.split(z, _offsets(ODD_WIDTHS), axis=-1)
            q = _rms(q.reshape(B_, S, N_HEADS, HEAD_DIM), dsa_qn[o])
            k = _rms(k.reshape(B_, S, N_HEADS, HEAD_DIM), dsa_kn[o])
            v = v.reshape(B_, S, N_HEADS, HEAD_DIM)
            qi = qi.reshape(B_, S, DSA_IDX_HEADS, DSA_IDX_DIM)
            wi = wi * (DSA_IDX_HEADS ** -0.5)
            y = jnp.concatenate([_dsa_attention(q, k, v, qi, wi, ki),
                                 _conv_module(ga, gb, conv_w[o], conv_b[o], conv_ln_g[o], conv_ln_b[o])], axis=-1)
        x = x + gate_res * ((y * jax.nn.silu(g)) @ w_out[l])
    return x
```

```cpp
#include <hip/hip_runtime.h>
#include <cstdio>
#include <cstdint>

#define LAS __attribute__((address_space(3)))
#define GAS __attribute__((address_space(1)))
typedef unsigned short bf16_t;
typedef short bf16x8 __attribute__((ext_vector_type(8)));
typedef short s16x4 __attribute__((ext_vector_type(4)));
typedef float f32x2 __attribute__((ext_vector_type(2)));
typedef float f32x4 __attribute__((ext_vector_type(4)));
typedef float f32x16 __attribute__((ext_vector_type(16)));
typedef unsigned u32x2 __attribute__((ext_vector_type(2)));
typedef unsigned u32x4 __attribute__((ext_vector_type(4)));

constexpr int SEQ = 16384, DM = 2048, HALFW = 1024, HD = 128, NH = 8;
constexpr int EV_N = 6144, OD_SRC_N = 7752, OD_N = 7936;
constexpr int EV_MAIN = 5120, OD_MAIN = 6912;
constexpr float EPS = 1e-6f;
constexpr float SCALE = 0.08838834764831845f;
constexpr float LOG2E = 1.4426950408889634f;
constexpr float C2 = SCALE * LOG2E;
constexpr float NEG_INF = -__builtin_inff();

constexpr size_t MiB = 1u << 20;
constexpr size_t WS_CTL = 0, CTL_ZERO_BYTES = 1 * MiB, CTL_KMEAN_OFF = 262144;
constexpr size_t WS_MODP = 1 * MiB, WS_MODF = 2 * MiB, WS_KMEAN = 3 * MiB, WS_PWT = 4 * MiB;
constexpr size_t WS_WOUT = 8 * MiB, WS_WEV = 40 * MiB, WS_WOD = 88 * MiB;
constexpr size_t WS_H = 150 * MiB, WS_SG = 214 * MiB, WS_Q = 278 * MiB, WS_K = 310 * MiB, WS_VT = 342 * MiB;
constexpr size_t WS_UA = 374 * MiB, WS_D = 406 * MiB, WS_LIST = 438 * MiB, WS_PARTO = 470 * MiB, WS_PARTML = 566 * MiB;
constexpr size_t WS_QI = 374 * MiB, WS_KI = 390 * MiB, WS_WI = 392 * MiB, WS_U = 394 * MiB, WS_MASK = 426 * MiB;
constexpr size_t WS_XB = 570 * MiB;
constexpr size_t WS_END = 634 * MiB;
constexpr int CW_BAR = 4096;
constexpr int CW_CNT = 16384;
constexpr int CW_KIMAX = 16384 + 2 * 512 * 16;
constexpr int CW_DQ = CW_KIMAX + 64;
static_assert((CW_DQ + 64) * 4 <= (int)CTL_ZERO_BYTES, "ctl");

constexpr int RING_BYTES = 131072;
constexpr int SCR_OFF = RING_BYTES;
constexpr int LDS_BYTES = 163840;
constexpr int MISC_OFF = LDS_BYTES - 256;

__device__ __forceinline__ unsigned cvt_pk_bf16(float lo, float hi) { unsigned r; asm volatile("v_cvt_pk_bf16_f32 %0, %1, %2" : "=v"(r) : "v"(lo), "v"(hi)); return r; }
__device__ __forceinline__ float bf2f(unsigned short b) { return __uint_as_float((unsigned)b << 16); }
__device__ __forceinline__ float bflo(unsigned w) { return __uint_as_float(w << 16); }
__device__ __forceinline__ float bfhi(unsigned w) { return __uint_as_float(w & 0xffff0000u); }
__device__ __forceinline__ int crow(int r, int hi) { return (r & 3) + 8 * (r >> 2) + 4 * hi; }
__device__ __forceinline__ float fast_exp2(float x) { return __builtin_amdgcn_exp2f(x); }
__device__ __forceinline__ float sigmoidf_(float x) { return __builtin_amdgcn_rcpf(1.0f + __expf(-x)); }
__device__ __forceinline__ float siluf_(float x) { return x * __builtin_amdgcn_rcpf(1.0f + __expf(-x)); }
#define LDS_WAIT() asm volatile("s_waitcnt lgkmcnt(0)" ::: "memory")
#define VM_WAIT() asm volatile("s_waitcnt vmcnt(0)" ::: "memory")
#define WG_BAR() do { asm volatile("s_waitcnt lgkmcnt(0)" ::: "memory"); __builtin_amdgcn_s_barrier(); asm volatile("" ::: "memory"); } while (0)

__device__ __forceinline__ int opaque_tid() { int t = threadIdx.x; asm volatile("" : "+v"(t)); return t; }

#define XB_TMO      128
#define XB_XCNT(j)  (256  + 64 * (j))
#define XB_XSUB(j)  (1280 + 64 * (j))
#define XB_XGEN(j)  (2304 + 64 * (j))
#define XB_TOP      3328
#define XB_TOPGEN   3392
#define XCD_BAR_WORDS 3456
#define XB_SPIN_CAP (1u << 18)

__device__ __forceinline__ unsigned xb_ld(unsigned* p)              { return __hip_atomic_load(p, __ATOMIC_RELAXED, __HIP_MEMORY_SCOPE_AGENT); }
__device__ __forceinline__ unsigned xb_add(unsigned* p, unsigned v) { return __hip_atomic_fetch_add(p, v, __ATOMIC_RELAXED, __HIP_MEMORY_SCOPE_AGENT); }
__device__ __forceinline__ unsigned xb_xcc_id() { return (unsigned)__builtin_amdgcn_s_getreg((3 << 11) | 20) & 0xFu; }
#define XB_SPIN(cond, bar) do { unsigned _sp = 0; while (cond) { __builtin_amdgcn_s_sleep(1); \
    if ((++_sp & 255u) == 0u) { if (xb_ld(&(bar)[XB_TMO])) break; if (_sp > XB_SPIN_CAP) { atomicAdd(&(bar)[XB_TMO], 1u); break; } } } } while (0)

struct XcdBarrier {
    unsigned* bar; unsigned x;
    volatile LAS unsigned* st;
};

__device__ __forceinline__ XcdBarrier xcd_barrier_post(unsigned* bar, volatile LAS unsigned* st) {
    XcdBarrier b; b.bar = bar; b.x = xb_xcc_id(); b.st = st;
    if (threadIdx.x == 0) (void)xb_add(&bar[XB_XCNT(b.x)], 1u);
    return b;
}
__device__ __forceinline__ void xcd_barrier_complete(unsigned* bar, unsigned x, unsigned& nloc, unsigned& nx) {
    const unsigned G = gridDim.x * gridDim.y * gridDim.z;
    unsigned sum, cnt, mine, sp = 0u;
    for (;;) {
        sum = 0u; cnt = 0u; mine = 0u;
#pragma unroll
        for (unsigned j = 0; j < 16; ++j) { const unsigned c = xb_ld(&bar[XB_XCNT(j)]); sum += c; cnt += (c > 0u) ? 1u : 0u; mine = (j == x) ? c : mine; }
        if (sum == G) break;
        __builtin_amdgcn_s_sleep(1);
        if ((++sp & 255u) == 0u) { if (xb_ld(&bar[XB_TMO])) break; if (sp > XB_SPIN_CAP) { atomicAdd(&bar[XB_TMO], 1u); break; } }
    }
    nloc = mine > 0u ? mine : 1u; nx = cnt > 0u ? cnt : 1u;
}

__device__ __forceinline__ void xcd_barrier(const XcdBarrier& b) {
    asm volatile("s_waitcnt vmcnt(0)" ::: "memory");
    __syncthreads();
    if (threadIdx.x == 0) {
        unsigned* bar = b.bar;
        __builtin_amdgcn_s_waitcnt(0);
        unsigned nloc = b.st[0], nx = b.st[1];
        if (nloc == 0u) { xcd_barrier_complete(bar, b.x, nloc, nx); b.st[0] = nloc; b.st[1] = nx; }
        const unsigned old = xb_add(&bar[XB_XSUB(b.x)], 1u);
        const unsigned gen = old / nloc;
        if (old + 1u == (gen + 1u) * nloc) {
            __builtin_amdgcn_fence(__ATOMIC_RELEASE, "agent");
            asm volatile("s_waitcnt vmcnt(0)" ::: "memory");
            const unsigned og = xb_add(&bar[XB_TOP], 1u);
            const unsigned tg = og / nx;
            if (og + 1u == (tg + 1u) * nx) xb_add(&bar[XB_TOPGEN], 1u);
            else XB_SPIN(xb_ld(&bar[XB_TOPGEN]) == tg, bar);
            __builtin_amdgcn_fence(__ATOMIC_ACQUIRE, "agent");
            xb_add(&bar[XB_XGEN(b.x)], 1u);
            asm volatile("s_waitcnt vmcnt(0)" ::: "memory");
        } else {
            XB_SPIN(xb_ld(&bar[XB_XGEN(b.x)]) == gen, bar);
            __builtin_amdgcn_fence(__ATOMIC_ACQUIRE, "agent");
            asm volatile("s_waitcnt vmcnt(0)" ::: "memory");
        }
    }
    __syncthreads();
}

namespace pg8 {
constexpr int BM = 256, BK = 64, HALF = 128, HTB = HALF * BK * 2, STAGE_BYTES = 8 * HTB, NXCD = 8, WGM = 4;
__host__ __device__ __forceinline__ int lds_byte(int r, int c) { const int st = (r >> 4) * 2 + (c >> 5), rr = r & 15, cc = c & 31, ob = rr * 64 + cc * 2; return st * 1024 + (ob ^ (((ob >> 9) & 1) << 5)); }
__host__ __device__ __forceinline__ void stage_rc(int b, int& R, int& C) { const int st = b / 1024, sb = b % 1024, swz = sb ^ (((sb >> 9) & 1) << 5); R = (st >> 1) * 16 + swz / 64; C = (st & 1) * 32 + (swz % 64) / 2; }
__host__ __device__ __forceinline__ int perm32(int rho) { const int n = rho >> 4, i = rho & 15; return 8 * (i >> 2) + 4 * n + (i & 3); }
struct Unit { int pm, pn; };
struct Gemm { const bf16_t* A; const bf16_t* Bt; int M, N, K; };
struct StaticOrder {
    int nM, nN, nwg, G, c;
    __device__ void init(int M, int N, int G_, int c_) { nM = M / BM; nN = N / BM; nwg = nM * nN; G = G_; c = c_; }
    __device__ bool next(int i, Unit& u) const {
        const long L = (long)i * G + c; if (L >= nwg) return false;
        int wgid = (int)L; { const int q = nwg / NXCD, r = nwg % NXCD, xcd = wgid % NXCD, off = wgid / NXCD; wgid = (xcd < r ? xcd * (q + 1) : r * (q + 1) + (xcd - r) * q) + off; }
        const int nig = WGM * nN, gid = wgid / nig, fm = gid * WGM, gsz = (nM - fm) < WGM ? (nM - fm) : WGM;
        u.pm = fm + ((wgid % nig) % gsz); u.pn = (wgid % nig) / gsz; return true;
    }
};
#ifdef REP7B
struct RepOrder {
    int nM, nN, nwg, G, c, reps;
    __device__ void init(int M, int N, int G_, int c_, int reps_) { nM = M / BM; nN = N / BM; nwg = nM * nN; G = G_; c = c_; reps = reps_; }
    __device__ bool next(int i, Unit& u) const {
        const long L = (long)i * G + c; if (L >= (long)nwg * reps) return false;
        int wgid = (int)(L % nwg); { const int q = nwg / NXCD, r = nwg % NXCD, xcd = wgid % NXCD, off = wgid / NXCD; wgid = (xcd < r ? xcd * (q + 1) : r * (q + 1) + (xcd - r) * q) + off; }
        const int nig = WGM * nN, gid = wgid / nig, fm = gid * WGM, gsz = (nM - fm) < WGM ? (nM - fm) : WGM;
        u.pm = fm + ((wgid % nig) % gsz); u.pn = (wgid % nig) / gsz; return true;
    }
};
#endif
struct PoolOrder {
    int G, c;
    __device__ bool next(int i, Unit& u) const { const int L = i * G + c; if (L >= 256) return false; u.pm = L; u.pn = L >> 6; return true; }
};

template <class Epi, class Sched>
__device__ __forceinline__ void gemm_phase(LAS unsigned char* lds, const Gemm g, const Sched& S, const Epi& E) {
    const int tid = opaque_tid(), wid = __builtin_amdgcn_readfirstlane(tid >> 6), lane = tid & 63, wr = wid >> 2, wc = wid & 3, fr = lane & 15, fq = lane >> 4;
    int K = g.K; asm volatile("" : "+s"(K));
    const int nt = K / BK;
    unsigned voffA, voffB;
    { int R, C; stage_rc(tid * 16, R, C); const int Rb = Epi::PERM ? ((R & ~31) + perm32(R & 31)) : R;
      voffA = (unsigned)(R * K + C) * 2u; voffB = (unsigned)(Rb * K + C) * 2u; }
    const size_t pstep = (size_t)64 * K * 2;
    const size_t kstep = (size_t)(BK * 2);
    const size_t hstep = (size_t)HALF * K * 2;
    const size_t tstep = 2 * hstep;
    const unsigned ldsw = (unsigned)wid * 1024u;
    const int aoff = lds_byte(wr * 64 + fr, fq * 8), boff = lds_byte(wc * 32 + fr, fq * 8);
#define PG8_SA(b, h) (((b) * 2 + (h)) * HTB)
#define PG8_SB(b, h) ((4 + (b) * 2 + (h)) * HTB)
#define PG8_STAGE(bufoff, gbase, voff) do { _Pragma("unroll") for (int _i = 0; _i < 2; ++_i) \
        __builtin_amdgcn_global_load_lds((const unsigned*)((const char*)(gbase) + _i * pstep + (voff)), (LAS unsigned*)(lds + (bufoff) + ldsw + _i * 8192), 16, 0, 0); } while (0)
#define PG8_LDA(dst, b, h) do { _Pragma("unroll") for (int m = 0; m < 4; ++m) _Pragma("unroll") for (int k = 0; k < 2; ++k) dst[m][k] = *(const LAS bf16x8*)(lds + PG8_SA(b, h) + aoff + m * 2048 + k * 1024); } while (0)
#define PG8_LDB(dst, b, h) do { _Pragma("unroll") for (int n = 0; n < 2; ++n) _Pragma("unroll") for (int k = 0; k < 2; ++k) dst[n][k] = *(const LAS bf16x8*)(lds + PG8_SB(b, h) + boff + n * 2048 + k * 1024); } while (0)
#define PG8_MMA(ai, bj, At, Bt) do { __builtin_amdgcn_s_setprio(1); _Pragma("unroll") for (int m = 0; m < 4; ++m) _Pragma("unroll") for (int n = 0; n < 2; ++n) _Pragma("unroll") for (int k = 0; k < 2; ++k) \
        acc[ai][bj][m][n] = __builtin_amdgcn_mfma_f32_16x16x32_bf16(Bt[n][k], At[m][k], acc[ai][bj][m][n], 0, 0, 0); __builtin_amdgcn_s_setprio(0); } while (0)
#define PG8_WAIT_V(n) asm volatile("s_waitcnt vmcnt(" #n ")" ::: "memory")
#define PG8_WAIT_L(n) asm volatile("s_waitcnt lgkmcnt(" #n ")" ::: "memory")
#define PG8_BAR __builtin_amdgcn_s_barrier()
#define PG8_SCHED __builtin_amdgcn_sched_barrier(0)
    Unit cur, nxt; int ui = 0;
    if (!S.next(0, cur)) return;
    f32x4 acc[2][2][4][2];
#pragma unroll
    for (int a = 0; a < 2; ++a)
#pragma unroll
        for (int b = 0; b < 2; ++b)
#pragma unroll
            for (int m = 0; m < 4; ++m)
#pragma unroll
                for (int n = 0; n < 2; ++n) acc[a][b][m][n] = (f32x4){0.f, 0.f, 0.f, 0.f};
    bf16x8 At[4][2], B0[2][2], B1[2][2];
    const char* cA = (const char*)g.A + (size_t)cur.pm * tstep; const char* cB = (const char*)g.Bt + (size_t)cur.pn * tstep;
#define PG8_FENCE asm volatile("" : "+v"(voffA), "+v"(voffB))
    PG8_FENCE; PG8_STAGE(PG8_SB(0, 0), cB, voffB); PG8_FENCE; PG8_STAGE(PG8_SB(0, 1), cB + hstep, voffB); PG8_FENCE; PG8_STAGE(PG8_SA(0, 0), cA, voffA); PG8_FENCE; PG8_STAGE(PG8_SA(0, 1), cA + hstep, voffA); PG8_FENCE;
    if (wr == 1) PG8_BAR;
    PG8_WAIT_V(2); PG8_BAR;
    PG8_STAGE(PG8_SB(1, 0), cB + kstep, voffB); PG8_FENCE; PG8_STAGE(PG8_SA(1, 0), cA + kstep, voffA); PG8_FENCE; PG8_STAGE(PG8_SB(1, 1), cB + hstep + kstep, voffB); PG8_FENCE;
    PG8_WAIT_V(6); PG8_BAR;
    for (;;) {
        const bool has_next = S.next(ui + 1, nxt);
        const char* nA = has_next ? (const char*)g.A + (size_t)nxt.pm * tstep : cA; const char* nB = has_next ? (const char*)g.Bt + (size_t)nxt.pn * tstep : cB;
#ifdef REPE
        const int ntt = nt * Epi::REPS;
        for (int t = 0; t < ntt; t += 2) {
            const bool last = (t == ntt - 2);
            const char* a1 = cA + (size_t)((t + 1) & (nt - 1)) * kstep;
            const char* a2 = last ? nA : cA + (size_t)((t + 2) & (nt - 1)) * kstep; const char* b2 = last ? nB : cB + (size_t)((t + 2) & (nt - 1)) * kstep;
#else
        for (int t = 0; t < nt; t += 2) {
            const bool last = (t == nt - 2);
            const char* a1 = cA + (size_t)(t + 1) * kstep;
            const char* a2 = last ? nA : cA + (size_t)(t + 2) * kstep; const char* b2 = last ? nB : cB + (size_t)(t + 2) * kstep;
#endif
            const char* a3 = a2 + kstep; const char* b3 = b2 + kstep;
            PG8_LDB(B0, 0, 0); PG8_LDB(B1, 0, 1); PG8_SCHED; PG8_LDA(At, 0, 0); PG8_STAGE(PG8_SA(1, 1), a1 + hstep, voffA);
            PG8_WAIT_V(8); PG8_WAIT_L(0); PG8_BAR; PG8_MMA(0, 0, At, B0); PG8_MMA(0, 1, At, B1); PG8_BAR; PG8_SCHED;
            PG8_LDA(At, 0, 1); PG8_STAGE(PG8_SB(0, 0), b2, voffB); PG8_STAGE(PG8_SB(0, 1), b2 + hstep, voffB); PG8_STAGE(PG8_SA(0, 0), a2, voffA);
            PG8_WAIT_V(8); PG8_WAIT_L(0); PG8_BAR; PG8_MMA(1, 0, At, B0); PG8_MMA(1, 1, At, B1); PG8_BAR; PG8_SCHED;
            PG8_LDB(B0, 1, 0); PG8_LDB(B1, 1, 1); PG8_SCHED; PG8_LDA(At, 1, 0); PG8_STAGE(PG8_SA(0, 1), a2 + hstep, voffA);
            PG8_WAIT_V(8); PG8_WAIT_L(0); PG8_BAR; PG8_MMA(0, 0, At, B0); PG8_MMA(0, 1, At, B1); PG8_BAR; PG8_SCHED;
            PG8_LDA(At, 1, 1); PG8_STAGE(PG8_SB(1, 0), b3, voffB); PG8_STAGE(PG8_SB(1, 1), b3 + hstep, voffB); PG8_STAGE(PG8_SA(1, 0), a3, voffA);
            PG8_WAIT_V(8); PG8_WAIT_L(0); PG8_BAR; PG8_MMA(1, 0, At, B0); PG8_MMA(1, 1, At, B1); PG8_BAR; PG8_SCHED;
        }
#ifdef REPE
        if (Epi::REPS == 2) {
#pragma unroll
            for (int a = 0; a < 2; ++a)
#pragma unroll
                for (int b = 0; b < 2; ++b)
#pragma unroll
                    for (int m = 0; m < 4; ++m)
#pragma unroll
                        for (int n = 0; n < 2; ++n) acc[a][b][m][n] = acc[a][b][m][n] * 0.5f;
        }
#endif
        if (wr == 0) PG8_BAR;
        E(acc, cur, wr, wc, fr, fq, wid, lane);
        if (!has_next) break;
#pragma unroll
        for (int a = 0; a < 2; ++a)
#pragma unroll
            for (int b = 0; b < 2; ++b)
#pragma unroll
                for (int m = 0; m < 4; ++m)
#pragma unroll
                    for (int n = 0; n < 2; ++n) acc[a][b][m][n] = (f32x4){0.f, 0.f, 0.f, 0.f};
        cur = nxt; cA = nA; cB = nB; ++ui;
        if (wr == 1) PG8_BAR;
    }
    PG8_WAIT_V(0);
    PG8_BAR;
#undef PG8_SA
#undef PG8_FENCE
#undef PG8_SB
#undef PG8_STAGE
#undef PG8_LDA
#undef PG8_LDB
#undef PG8_MMA
#undef PG8_WAIT_V
#undef PG8_WAIT_L
#undef PG8_BAR
#undef PG8_SCHED
}
}

namespace epi {
using pg8::Unit;
__device__ __forceinline__ void st8(bf16_t* p, const f32x4 v0, const f32x4 v1) {
    u32x4 w; w.x = cvt_pk_bf16(v0[0], v0[1]); w.y = cvt_pk_bf16(v0[2], v0[3]); w.z = cvt_pk_bf16(v1[0], v1[1]); w.w = cvt_pk_bf16(v1[2], v1[3]);
    *(u32x4*)p = w;
}
__device__ __forceinline__ float sumsq8(const f32x4 a, const f32x4 b) { return (a[0] * a[0] + a[1] * a[1]) + (a[2] * a[2] + a[3] * a[3]) + (b[0] * b[0] + b[1] * b[1]) + (b[2] * b[2] + b[3] * b[3]); }
__device__ __forceinline__ f32x4 silu4(const f32x4 v) { return (f32x4){siluf_(v[0]), siluf_(v[1]), siluf_(v[2]), siluf_(v[3])}; }

template <bool KMEAN_>
__device__ __forceinline__ void qk_norm_store(const f32x4 (&acc)[2][2][4][2], const Unit& u, int wr, int wc, int fr, int fq, int wid, int lane,
                                              LAS unsigned char* scr, const float* gn, bf16_t* dst, int head0, float* kmean) {
    LAS float* P = (LAS float*)scr;
#pragma unroll
    for (int ai = 0; ai < 2; ++ai)
#pragma unroll
        for (int m = 0; m < 4; ++m)
#pragma unroll
            for (int bj = 0; bj < 2; ++bj) {
                float ss = sumsq8(acc[ai][bj][m][0], acc[ai][bj][m][1]);
                ss += __shfl_xor(ss, 16); ss += __shfl_xor(ss, 32);
                if (fq == 0) P[((ai * 128 + wr * 64 + m * 16 + fr) * 2 + bj) * 4 + wc] = ss;
                __builtin_amdgcn_sched_barrier(0);
            }
    WG_BAR();
    const f32x4 g0 = *(const f32x4*)(gn + 32 * wc + 8 * fq), g1 = *(const f32x4*)(gn + 32 * wc + 8 * fq + 4);
#pragma unroll
    for (int ai = 0; ai < 2; ++ai)
#pragma unroll
        for (int m = 0; m < 4; ++m)
#pragma unroll
            for (int bj = 0; bj < 2; ++bj) {
                const int rl = ai * 128 + wr * 64 + m * 16 + fr;
                const f32x4 p4 = *(const LAS f32x4*)&P[(rl * 2 + bj) * 4];
                const float rstd = __builtin_amdgcn_rsqf(((p4[0] + p4[1]) + (p4[2] + p4[3])) * (1.0f / 128.0f) + EPS);
                const f32x4 v0 = acc[ai][bj][m][0] * rstd * g0, v1 = acc[ai][bj][m][1] * rstd * g1;
                st8(dst + ((size_t)(head0 + bj) * SEQ + (size_t)(u.pm * 256 + rl)) * HD + 32 * wc + 8 * fq, v0, v1);
                __builtin_amdgcn_sched_barrier(0);
            }
    if (KMEAN_) {
        __builtin_amdgcn_sched_barrier(0);
#pragma unroll
        for (int bj = 0; bj < 2; ++bj)
#pragma unroll
            for (int n = 0; n < 2; ++n) {
                f32x4 c4 = (f32x4){0.f, 0.f, 0.f, 0.f};
#pragma unroll
                for (int ai = 0; ai < 2; ++ai)
#pragma unroll
                    for (int m = 0; m < 4; ++m) {
                        const int rl = ai * 128 + wr * 64 + m * 16 + fr;
                        const f32x4 p4 = *(const LAS f32x4*)&P[(rl * 2 + bj) * 4];
                        const float rstd = __builtin_amdgcn_rsqf(((p4[0] + p4[1]) + (p4[2] + p4[3])) * (1.0f / 128.0f) + EPS);
                        c4 += acc[ai][bj][m][n] * rstd;
                    }
                c4 = c4 * (n == 0 ? g0 : g1);
#pragma unroll
                for (int e = 0; e < 4; ++e) {
                    float s = c4[e];
                    s += __shfl_xor(s, 1); s += __shfl_xor(s, 2); s += __shfl_xor(s, 4); s += __shfl_xor(s, 8);
                    if (fr == 0) atomicAdd(kmean + ((size_t)(head0 + bj) * 64 + u.pm) * HD + 32 * wc + 8 * fq + 4 * n + e, s * (1.0f / 256.0f));
                }
                __builtin_amdgcn_sched_barrier(0);
            }
    }
}

struct EpiEven {
    static constexpr bool PERM = true;
#ifdef REPE
    static constexpr int REPS = REPE_EVEN;
#endif
    unsigned char* ws; float* KMEAN; const float *qn, *kn; LAS unsigned char* scr;
    __device__ __forceinline__ void operator()(const f32x4 (&acc)[2][2][4][2], const Unit& u, int wr, int wc, int fr, int fq, int wid, int lane) const {
        asm volatile("" : "+v"(fr), "+v"(fq), "+v"(lane));
        const int pn = u.pn, row0 = u.pm * 256 + wr * 64 + fr;
        bf16_t* UA = (bf16_t*)(ws + WS_UA); bf16_t* Q = (bf16_t*)(ws + WS_Q); bf16_t* K = (bf16_t*)(ws + WS_K); bf16_t* SG = (bf16_t*)(ws + WS_SG);
        if (pn < 4) {
#pragma unroll
            for (int ai = 0; ai < 2; ++ai)
#pragma unroll
                for (int m = 0; m < 4; ++m) { bf16_t* rp = UA + (size_t)(row0 + ai * 128 + m * 16) * HALFW + pn * 256 + wc * 32 + 8 * fq;
#pragma unroll
                    for (int bj = 0; bj < 2; ++bj) st8(rp + bj * 128, acc[ai][bj][m][0], acc[ai][bj][m][1]); }
        } else if (pn < 8) {
            qk_norm_store<false>(acc, u, wr, wc, fr, fq, wid, lane, scr, qn, Q, 2 * (pn - 4), nullptr);
        } else if (pn < 12) {
            qk_norm_store<true>(acc, u, wr, wc, fr, fq, wid, lane, scr, kn, K, 2 * (pn - 8), KMEAN);
        } else {
#pragma unroll
            for (int ai = 0; ai < 2; ++ai)
#pragma unroll
                for (int m = 0; m < 4; ++m) { bf16_t* rp = SG + (size_t)(row0 + ai * 128 + m * 16) * DM + (pn - 12) * 256 + wc * 32 + 8 * fq;
#pragma unroll
                    for (int bj = 0; bj < 2; ++bj) st8(rp + bj * 128, silu4(acc[ai][bj][m][0]), silu4(acc[ai][bj][m][1])); }
        }
    }
};

struct EpiOdd {
    static constexpr bool PERM = true;
#ifdef REPE
    static constexpr int REPS = REPE_ODD;
#endif
    unsigned char* ws; unsigned* KIMAX; const float *qn, *kn; LAS unsigned char* scr;
    __device__ __forceinline__ void operator()(const f32x4 (&acc)[2][2][4][2], const Unit& u, int wr, int wc, int fr, int fq, int wid, int lane) const {
        asm volatile("" : "+v"(fr), "+v"(fq), "+v"(lane));
        const int pn = u.pn, row0 = u.pm * 256 + wr * 64 + fr;
        bf16_t* Q = (bf16_t*)(ws + WS_Q); bf16_t* K = (bf16_t*)(ws + WS_K); bf16_t* QI = (bf16_t*)(ws + WS_QI); bf16_t* KI = (bf16_t*)(ws + WS_KI); bf16_t* U = (bf16_t*)(ws + WS_U); bf16_t* SG = (bf16_t*)(ws + WS_SG); float* WI = (float*)(ws + WS_WI);
        if (pn < 4) {
            qk_norm_store<false>(acc, u, wr, wc, fr, fq, wid, lane, scr, qn, Q, 2 * pn, nullptr);
        } else if (pn < 8) {
            qk_norm_store<false>(acc, u, wr, wc, fr, fq, wid, lane, scr, kn, K, 2 * (pn - 4), nullptr);
        } else if (pn < 10) {
#pragma unroll
            for (int ai = 0; ai < 2; ++ai)
#pragma unroll
                for (int m = 0; m < 4; ++m) { bf16_t* rp = QI + (size_t)(row0 + ai * 128 + m * 16) * 512 + (pn - 8) * 256 + wc * 32 + 8 * fq;
#pragma unroll
                    for (int bj = 0; bj < 2; ++bj) {
#ifdef PROBE_QITRUNC
                        u32x4 w_; w_.x = cvt_pk_bf16(acc[ai][bj][m][0][0], acc[ai][bj][m][0][1]) & 0xFFFEFFFEu; w_.y = cvt_pk_bf16(acc[ai][bj][m][0][2], acc[ai][bj][m][0][3]) & 0xFFFEFFFEu; w_.z = cvt_pk_bf16(acc[ai][bj][m][1][0], acc[ai][bj][m][1][1]) & 0xFFFEFFFEu; w_.w = cvt_pk_bf16(acc[ai][bj][m][1][2], acc[ai][bj][m][1][3]) & 0xFFFEFFFEu; *(u32x4*)(rp + bj * 128) = w_;
#else
                        st8(rp + bj * 128, acc[ai][bj][m][0], acc[ai][bj][m][1]);
#endif
                    } }
        } else if (pn == 10) {
            if (wc < 2) {
                float mx = 0.f;
#pragma unroll
                for (int ai = 0; ai < 2; ++ai)
#pragma unroll
                    for (int m = 0; m < 4; ++m) {
                        st8(KI + (size_t)(row0 + ai * 128 + m * 16) * 64 + wc * 32 + 8 * fq, acc[ai][0][m][0], acc[ai][0][m][1]);
                        mx = fmaxf(mx, sumsq8(acc[ai][0][m][0], acc[ai][0][m][1]));
                    }
                mx = fmaxf(mx, __shfl_xor(mx, 1)); mx = fmaxf(mx, __shfl_xor(mx, 2)); mx = fmaxf(mx, __shfl_xor(mx, 4)); mx = fmaxf(mx, __shfl_xor(mx, 8));
                if (fr == 0) atomicMax(KIMAX + wc * 4 + fq, __float_as_uint(mx));
            } else if (wc == 2 && fq == 0) {
                const float s = 0.35355339059327373f;
#pragma unroll
                for (int ai = 0; ai < 2; ++ai)
#pragma unroll
                    for (int m = 0; m < 4; ++m) { float* wp = WI + (size_t)(row0 + ai * 128 + m * 16) * 8;
                        *(f32x4*)wp = acc[ai][0][m][0] * s; *(f32x4*)(wp + 4) = acc[ai][0][m][1] * s; }
            }
        } else if (pn < 19) {
            const int j = pn - 11;
#pragma unroll
            for (int ai = 0; ai < 2; ++ai)
#pragma unroll
                for (int m = 0; m < 4; ++m) {
                    f32x4 u0, u1;
#pragma unroll
                    for (int e = 0; e < 4; ++e) { u0[e] = acc[ai][0][m][0][e] * sigmoidf_(acc[ai][1][m][0][e]); u1[e] = acc[ai][0][m][1][e] * sigmoidf_(acc[ai][1][m][1][e]); }
                    st8(U + (size_t)(row0 + ai * 128 + m * 16) * HALFW + j * 128 + wc * 32 + 8 * fq, u0, u1);
                }
        } else {
#pragma unroll
            for (int ai = 0; ai < 2; ++ai)
#pragma unroll
                for (int m = 0; m < 4; ++m) { bf16_t* rp = SG + (size_t)(row0 + ai * 128 + m * 16) * DM + (pn - 19) * 256 + wc * 32 + 8 * fq;
#pragma unroll
                    for (int bj = 0; bj < 2; ++bj) st8(rp + bj * 128, silu4(acc[ai][bj][m][0]), silu4(acc[ai][bj][m][1])); }
        }
    }
};

struct EpiVT {
    static constexpr bool PERM = true;
#ifdef REPE
    static constexpr int REPS = REPE_VT;
#endif
    bf16_t* VT;
    __device__ __forceinline__ void operator()(const f32x4 (&acc)[2][2][4][2], const Unit& u, int wr, int wc, int fr, int fq, int wid, int lane) const {
        asm volatile("" : "+v"(fr), "+v"(fq), "+v"(lane));
        const int row0 = u.pm * 256 + wr * 64 + fr;
#pragma unroll
        for (int ai = 0; ai < 2; ++ai)
#pragma unroll
            for (int m = 0; m < 4; ++m) { bf16_t* rp = VT + (size_t)(row0 + ai * 128 + m * 16) * SEQ + u.pn * 256 + wc * 32 + 8 * fq;
#pragma unroll
                for (int bj = 0; bj < 2; ++bj) st8(rp + bj * 128, acc[ai][bj][m][0], acc[ai][bj][m][1]); }
    }
};

struct EpiPool {
    static constexpr bool PERM = true;
#ifdef REPE
    static constexpr int REPS = REPE_POOL;
#endif
    const float* pscale; const bf16_t* SG; bf16_t* YG;
    __device__ __forceinline__ void operator()(const f32x4 (&acc)[2][2][4][2], const Unit& u, int wr, int wc, int fr, int fq, int wid, int lane) const {
        asm volatile("" : "+v"(fr), "+v"(fq), "+v"(lane));
        const int row0 = (u.pm & 63) * 256 + wr * 64 + fr;
#pragma unroll
        for (int bj = 0; bj < 2; ++bj) {
            const int col = u.pn * 256 + bj * 128 + wc * 32 + 8 * fq;
            u32x4 gv[1][2][4];
#pragma unroll
            for (int ai = 0; ai < 2; ++ai)
#pragma unroll
                for (int m = 0; m < 4; ++m) gv[0][ai][m] = *(const u32x4*)(SG + (size_t)(row0 + ai * 128 + m * 16) * DM + col);
            const f32x4 p0 = *(const f32x4*)(pscale + col), p1 = *(const f32x4*)(pscale + col + 4);
            __builtin_amdgcn_sched_barrier(0);
#pragma unroll
            for (int ai = 0; ai < 2; ++ai)
#pragma unroll
                for (int m = 0; m < 4; ++m) { const size_t o = (size_t)(row0 + ai * 128 + m * 16) * DM + col;
                    const u32x4 g = gv[0][ai][m];
                    const f32x4 g0 = (f32x4){bflo(g.x), bfhi(g.x), bflo(g.y), bfhi(g.y)}, g1 = (f32x4){bflo(g.z), bfhi(g.z), bflo(g.w), bfhi(g.w)};
                    st8(YG + o, acc[ai][bj][m][0] * p0 * g0, acc[ai][bj][m][1] * p1 * g1); }
            __builtin_amdgcn_sched_barrier(0);
        }
    }
};

template <bool IN_BF, bool OUT_BF>
struct EpiOut {
    static constexpr bool PERM = true;
#ifdef REPE
    static constexpr int REPS = REPE_OUT;
#endif
    const void* xin; void* xout; const float* gate; LAS unsigned char* scr;
    __device__ __forceinline__ void operator()(const f32x4 (&acc)[2][2][4][2], const Unit& u, int wr, int wc, int fr, int fq, int wid, int lane) const {
        asm volatile("" : "+v"(fr), "+v"(fq), "+v"(lane));
        LAS unsigned char* st = scr + wid * 2304;
        const int lr = lane >> 3, lp = lane & 7;
        const int rowb = u.pm * 256 + wr * 64, colb = u.pn * 256 + 64 * wc;
        f32x4 g[2][2];
#pragma unroll
        for (int bj = 0; bj < 2; ++bj)
#pragma unroll
            for (int n = 0; n < 2; ++n) g[bj][n] = *(const f32x4*)(gate + colb + 32 * bj + 8 * fq + 4 * n);
        u32x4 xa[4], xb[4], xc[4];
#define EO_RT(k) (rowb + ((k) >> 2) * 128 + ((k) & 3) * 16)
#define EO_LD(buf, k) do { if (IN_BF) { _Pragma("unroll") for (int j = 0; j < 2; ++j) buf[j] = *(const u32x4*)((const bf16_t*)xin + (size_t)(EO_RT(k) + lr + 8 * j) * DM + colb + 8 * lp); } \
        else { _Pragma("unroll") for (int q = 0; q < 4; ++q) buf[q] = *(const u32x4*)((const float*)xin + (size_t)(EO_RT(k) + fr) * DM + colb + 32 * (q >> 1) + 8 * fq + 4 * (q & 1)); } \
        __builtin_amdgcn_sched_barrier(0); } while (0)
#define EO_PROC(buf, k) do { f32x4 v[2][2]; \
        if (IN_BF) { _Pragma("unroll") for (int j = 0; j < 2; ++j) *(LAS u32x4*)(st + (lr + 8 * j) * 144 + 16 * lp) = buf[j]; \
            asm volatile("" ::: "memory"); \
            _Pragma("unroll") for (int bj = 0; bj < 2; ++bj) { const u32x4 xf = *(const LAS u32x4*)(st + fr * 144 + 16 * (4 * bj + fq)); \
                v[bj][0] = (f32x4){bflo(xf.x), bfhi(xf.x), bflo(xf.y), bfhi(xf.y)} + g[bj][0] * acc[(k) >> 2][bj][(k) & 3][0]; v[bj][1] = (f32x4){bflo(xf.z), bfhi(xf.z), bflo(xf.w), bfhi(xf.w)} + g[bj][1] * acc[(k) >> 2][bj][(k) & 3][1]; } \
            asm volatile("" ::: "memory"); } \
        else { _Pragma("unroll") for (int bj = 0; bj < 2; ++bj) _Pragma("unroll") for (int n = 0; n < 2; ++n) { const u32x4 xq = buf[2 * bj + n]; \
                v[bj][n] = (f32x4){__uint_as_float(xq.x), __uint_as_float(xq.y), __uint_as_float(xq.z), __uint_as_float(xq.w)} + g[bj][n] * acc[(k) >> 2][bj][(k) & 3][n]; } } \
        if (OUT_BF) { _Pragma("unroll") for (int bj = 0; bj < 2; ++bj) { u32x4 w; w.x = cvt_pk_bf16(v[bj][0][0], v[bj][0][1]); w.y = cvt_pk_bf16(v[bj][0][2], v[bj][0][3]); w.z = cvt_pk_bf16(v[bj][1][0], v[bj][1][1]); w.w = cvt_pk_bf16(v[bj][1][2], v[bj][1][3]); \
                *(LAS u32x4*)(st + fr * 144 + 16 * (4 * bj + fq)) = w; } \
            asm volatile("" ::: "memory"); \
            _Pragma("unroll") for (int j = 0; j < 2; ++j) { const u32x4 r = *(const LAS u32x4*)(st + (lr + 8 * j) * 144 + 16 * lp); *(u32x4*)((bf16_t*)xout + (size_t)(EO_RT(k) + lr + 8 * j) * DM + colb + 8 * lp) = r; } \
            asm volatile("" ::: "memory"); } \
        else { _Pragma("unroll") for (int bj = 0; bj < 2; ++bj) { *(LAS f32x4*)(st + fr * 144 + 32 * fq) = v[bj][0]; *(LAS f32x4*)(st + fr * 144 + 32 * fq + 16) = v[bj][1]; \
                asm volatile("" ::: "memory"); \
                _Pragma("unroll") for (int j = 0; j < 2; ++j) { const f32x4 r = *(const LAS f32x4*)(st + (lr + 8 * j) * 144 + 16 * lp); *(f32x4*)((float*)xout + (size_t)(EO_RT(k) + lr + 8 * j) * DM + colb + 32 * bj + 4 * lp) = r; } \
                asm volatile("" ::: "memory"); } } \
        __builtin_amdgcn_sched_barrier(0); } while (0)
        EO_LD(xa, 0); EO_LD(xb, 1); EO_LD(xc, 2); EO_PROC(xa, 0); EO_LD(xa, 3); EO_PROC(xb, 1); EO_LD(xb, 4); EO_PROC(xc, 2); EO_LD(xc, 5); EO_PROC(xa, 3); EO_LD(xa, 6); EO_PROC(xb, 4); EO_LD(xb, 7); EO_PROC(xc, 5); EO_PROC(xa, 6); EO_PROC(xb, 7);
#undef EO_RT
#undef EO_LD
#undef EO_PROC
    }
};
#ifdef REP7B
struct EpiOutProbe {
    static constexpr bool PERM = true;
    const float* xin; float* xout; const float* gate; int mode;
    __device__ __forceinline__ void operator()(const f32x4 (&acc)[2][2][4][2], const Unit& u, int wr, int wc, int fr, int fq, int wid, int lane) const {
        asm volatile("" : "+v"(fr), "+v"(fq), "+v"(lane));
        const size_t o0 = (size_t)(u.pm * 256 + wr * 64 + fr) * DM + u.pn * 256 + wc * 32 + 8 * fq;
        const float* xi = xin + o0; float* xo = xout + o0;
        f32x4 sum = (f32x4){0.f, 0.f, 0.f, 0.f};
#pragma unroll
        for (int b = 0; b < 4; ++b) {
            f32x4 xa[4][2];
#pragma unroll
            for (int m = 0; m < 4; ++m) { xa[m][0] = (f32x4){0.f, 0.f, 0.f, 0.f}; xa[m][1] = xa[m][0]; }
            if (mode & 1) {
#pragma unroll
                for (int m = 0; m < 4; ++m) { const float* p_ = xi + (size_t)((b & 1) * 128 + m * 16) * DM + (b >> 1) * 128; xa[m][0] = *(const f32x4*)p_; xa[m][1] = *(const f32x4*)(p_ + 4); }
            }
            __builtin_amdgcn_sched_barrier(0);
#pragma unroll
            for (int m = 0; m < 4; ++m) { float* p_ = xo + (size_t)((b & 1) * 128 + m * 16) * DM + (b >> 1) * 128;
                const f32x4 v0 = xa[m][0] + acc[b & 1][b >> 1][m][0], v1 = xa[m][1] + acc[b & 1][b >> 1][m][1];
                if (mode & 8) { const int k_ = b * 8 + m * 2;
                    float* q0 = xout + (size_t)(u.pm * 256 + 32 * wid + 8 * (k_ >> 3) + (lane >> 3)) * DM + u.pn * 256 + (k_ & 7) * 32 + (lane & 7) * 4;
                    float* q1 = xout + (size_t)(u.pm * 256 + 32 * wid + 8 * ((k_ + 1) >> 3) + (lane >> 3)) * DM + u.pn * 256 + ((k_ + 1) & 7) * 32 + (lane & 7) * 4;
                    *(f32x4*)q0 = v0; *(f32x4*)q1 = v1; }
                else if (mode & 4) st8((bf16_t*)xout + (o0 + (size_t)((b & 1) * 128 + m * 16) * DM + (b >> 1) * 128), v0, v1); else if (mode & 2) { *(f32x4*)p_ = v0; *(f32x4*)(p_ + 4) = v1; } else sum += v0 * v1; }
            __builtin_amdgcn_sched_barrier(0);
        }
        if (!(mode & 14) && sum[0] + sum[1] + sum[2] + sum[3] == 1.2345e38f) xo[0] = sum[0];
    }
};
#endif
}

struct Frame {
    LAS unsigned char* lds;
    unsigned* ctl;
    int tid, lane, wave, G, bid;
};
__device__ __forceinline__ float wave_sum(float v) {
#pragma unroll
    for (int o = 1; o < 64; o <<= 1) v += __shfl_xor(v, o);
    return v;
}

struct MapId { __device__ __forceinline__ int operator()(int n) const { return n; } };
__device__ __forceinline__ int tile_sigma(int n) { return (n & ~255) | (((n >> 5) & 3) << 6) | (((n >> 7) & 1) << 5) | (n & 31); }
struct MapSig { __device__ __forceinline__ int operator()(int n) const { return tile_sigma(n); } };
struct MapEven { __device__ __forceinline__ int operator()(int n) const { return n < 3072 ? n : (n < 5120 ? n + 1024 : n - 2048); } };
struct MapOdd { __device__ __forceinline__ int operator()(int n) const {
    if (n < 2048) return n;
    if (n < 2560) return 3072 + (n - 2048);
    if (n < 2816) { const int r = n - 2560; return r < 64 ? 3592 + r : (r < 72 ? 3584 + (r - 64) : -1); }
    if (n < 4864) { const int r = n - 2816, j = r >> 8, i = r & 255; return i < 128 ? 3656 + 128 * j + i : 4680 + 128 * j + (i - 128); }
    if (n < 6912) return 5704 + (n - 4864);
    return 2048 + (n - 6912); } };
template <class F>
__device__ __forceinline__ void transpose_item(const float* W, int K, int N, bf16_t* WT, LAS float* scr, int item, int ndb, int lane, F srccol) {
    const int kb = item / ndb, nb = item % ndb, k0 = 64 * kb, n0 = 32 * nb;
    const int sc = srccol(n0 + (lane & 31));
    float tv[32];
#pragma unroll
    for (int i = 0; i < 32; ++i) { const int kk = 2 * i + (lane >> 5); tv[i] = W[(size_t)(k0 + kk) * N + (sc >= 0 ? sc : 0)]; }
#pragma unroll
    for (int i = 0; i < 32; ++i) { const int kk = 2 * i + (lane >> 5); scr[kk * 33 + (lane & 31)] = sc >= 0 ? tv[i] : 0.f; }
    LDS_WAIT(); asm volatile("" ::: "memory");
    const int c = lane & 7;
#pragma unroll
    for (int j = 0; j < 4; ++j) { const int n = (lane >> 3) + 8 * j; const LAS float* s = scr + (8 * c) * 33 + n;
        u32x4 o; o.x = cvt_pk_bf16(s[0 * 33], s[1 * 33]); o.y = cvt_pk_bf16(s[2 * 33], s[3 * 33]); o.z = cvt_pk_bf16(s[4 * 33], s[5 * 33]); o.w = cvt_pk_bf16(s[6 * 33], s[7 * 33]);
        *(u32x4*)(WT + (size_t)(n0 + n) * K + k0 + 8 * c) = o; }
    LDS_WAIT(); asm volatile("" ::: "memory");
}
__device__ __forceinline__ void phase_p0a(Frame& F, const float* cvec, const float* ada_w, const float* w_out, const float* ev_w, const float* pool_w, const float* od_w, unsigned char* ws) {
    LAS float* sil = (LAS float*)(F.lds + SCR_OFF);
    float* modp = (float*)(ws + WS_MODP);
    for (int it = F.bid; it < 4 * 8 * 12; it += F.G) {
        const int jb = it % 12, ch = (it / 12) % 8, l = it / 96;
        __syncthreads();
        if (F.tid < 256) sil[F.tid] = siluf_(cvec[ch * 256 + F.tid]);
        __syncthreads();
        const float* wp = ada_w + ((size_t)l * DM + ch * 256) * 6144 + jb * 512 + F.tid;
        float a0 = 0.f, a1 = 0.f, a2 = 0.f, a3 = 0.f;
        for (int i = 0; i < 256; i += 16) {
            float v[16];
#pragma unroll
            for (int k = 0; k < 16; ++k) v[k] = wp[(size_t)(i + k) * 6144];
#pragma unroll
            for (int k = 0; k < 16; k += 4) { a0 = fmaf(sil[i + k], v[k], a0); a1 = fmaf(sil[i + k + 1], v[k + 1], a1); a2 = fmaf(sil[i + k + 2], v[k + 2], a2); a3 = fmaf(sil[i + k + 3], v[k + 3], a3); }
        }
        modp[((size_t)ch * 4 + l) * 6144 + jb * 512 + F.tid] = (a0 + a1) + (a2 + a3);
    }
    __syncthreads();
    LAS float* scr = (LAS float*)(F.lds + F.wave * 16384);
    const int gw = F.bid * 8 + F.wave, NGW = F.G * 8;
    constexpr int I_EV = 32 * 192, I_OD = 32 * 248, I_OUT = 32 * 64, I_PW = 4 * 8;
    constexpr int NIT = 2 * I_EV + 2 * I_OD + 4 * I_OUT + 8 * I_PW;
    for (int it = gw; it < NIT; it += NGW) {
        int r = it;
        if (r < 2 * I_EV) { const int e = r / I_EV; transpose_item(ev_w + (size_t)e * DM * EV_N, DM, EV_N, (bf16_t*)(ws + WS_WEV) + (size_t)e * EV_N * DM, scr, r % I_EV, 192, F.lane, MapEven()); continue; } r -= 2 * I_EV;
        if (r < 2 * I_OD) { const int e = r / I_OD; transpose_item(od_w + (size_t)e * DM * OD_SRC_N, DM, OD_SRC_N, (bf16_t*)(ws + WS_WOD) + (size_t)e * OD_N * DM, scr, r % I_OD, 248, F.lane, MapOdd()); continue; } r -= 2 * I_OD;
        if (r < 4 * I_OUT) { const int e = r / I_OUT; transpose_item(w_out + (size_t)e * DM * DM, DM, DM, (bf16_t*)(ws + WS_WOUT) + (size_t)e * DM * DM, scr, r % I_OUT, 64, F.lane, MapSig()); continue; } r -= 4 * I_OUT;
        { const int e = r / I_PW; transpose_item(pool_w + (size_t)e * 65536, 256, 256, (bf16_t*)(ws + WS_PWT) + (size_t)e * 65536, scr, r % I_PW, 8, F.lane, MapId()); }
    }
}
__device__ __forceinline__ void phase_p0b(Frame& F, const float* ada_b, unsigned char* ws) {
    const float* modp = (const float*)(ws + WS_MODP); float* modf = (float*)(ws + WS_MODF);
    for (int i = F.bid * 512 + F.tid; i < 4 * 6144; i += F.G * 512) {
        float s = ada_b[i];
#pragma unroll
        for (int c = 0; c < 8; ++c) s += modp[(size_t)c * 4 * 6144 + i];
        modf[i] = s;
    }
}

template <bool BF>
__device__ __forceinline__ void phase_norm(Frame& F, const void* xin_, const float* norm_g, const float* mod, bf16_t* H) {
    if (BF) {
        const int gw = F.bid * 8 + F.wave, NGW = F.G * 8;
        const bf16_t* xin = (const bf16_t*)xin_;
        f32x4 gs[8], sh[8];
        { f32x4 g_[8], sc_[8];
#pragma unroll
          for (int j = 0; j < 8; ++j) { const int c = 8 * F.lane + 512 * (j >> 1) + 4 * (j & 1); g_[j] = *(const f32x4*)(norm_g + c); sc_[j] = *(const f32x4*)(mod + DM + c); sh[j] = *(const f32x4*)(mod + c); }
          __builtin_amdgcn_sched_barrier(0);
#pragma unroll
          for (int j = 0; j < 8; ++j) gs[j] = g_[j] * (sc_[j] + 1.0f); }
        u32x4 w0[4], w1[4], w2[4];
        { const int r0 = gw < SEQ ? gw : SEQ - 1, r1 = gw + NGW < SEQ ? gw + NGW : SEQ - 1;
          const u32x4* xa = (const u32x4*)(xin + (size_t)r0 * DM) + F.lane; const u32x4* xb = (const u32x4*)(xin + (size_t)r1 * DM) + F.lane;
#pragma unroll
          for (int j = 0; j < 4; ++j) { w0[j] = xa[64 * j]; w1[j] = xb[64 * j]; } }
        for (int row = gw; row < SEQ; row += NGW) {
            const int rn = row + 2 * NGW < SEQ ? row + 2 * NGW : row;
            { const u32x4* xr = (const u32x4*)(xin + (size_t)rn * DM) + F.lane;
#pragma unroll
              for (int j = 0; j < 4; ++j) w2[j] = xr[64 * j]; }
            f32x4 v[8];
#pragma unroll
            for (int j = 0; j < 4; ++j) { v[2 * j] = (f32x4){bflo(w0[j].x), bfhi(w0[j].x), bflo(w0[j].y), bfhi(w0[j].y)}; v[2 * j + 1] = (f32x4){bflo(w0[j].z), bfhi(w0[j].z), bflo(w0[j].w), bfhi(w0[j].w)}; }
            float s = 0.f;
#pragma unroll
            for (int j = 0; j < 8; ++j) s += (v[j][0] * v[j][0] + v[j][1] * v[j][1]) + (v[j][2] * v[j][2] + v[j][3] * v[j][3]);
            const float rstd = __builtin_amdgcn_rsqf(wave_sum(s) * (1.0f / DM) + EPS);
            u32x4* op = (u32x4*)(H + (size_t)row * DM) + F.lane;
#pragma unroll
            for (int j = 0; j < 4; ++j) { const f32x4 y0 = v[2 * j] * rstd * gs[2 * j] + sh[2 * j], y1 = v[2 * j + 1] * rstd * gs[2 * j + 1] + sh[2 * j + 1];
                u32x4 w; w.x = cvt_pk_bf16(y0[0], y0[1]); w.y = cvt_pk_bf16(y0[2], y0[3]); w.z = cvt_pk_bf16(y1[0], y1[1]); w.w = cvt_pk_bf16(y1[2], y1[3]); op[64 * j] = w; }
#pragma unroll
            for (int j = 0; j < 4; ++j) { w0[j] = w1[j]; w1[j] = w2[j]; }
        }
        return;
    }
    const float* xin = (const float*)xin_;
    f32x4 gs[8], sh[8];
    { f32x4 g_[8], sc_[8];
#pragma unroll
      for (int j = 0; j < 8; ++j) { const int c = 4 * F.lane + 256 * j; g_[j] = *(const f32x4*)(norm_g + c); sc_[j] = *(const f32x4*)(mod + DM + c); sh[j] = *(const f32x4*)(mod + c); }
      __builtin_amdgcn_sched_barrier(0);
#pragma unroll
      for (int j = 0; j < 8; ++j) gs[j] = g_[j] * (sc_[j] + 1.0f); }
    const int gw = F.bid * 8 + F.wave, NGW = F.G * 8;
    f32x4 v[8], vn[8];
    if (gw < SEQ) { const f32x4* xr = (const f32x4*)(xin + (size_t)gw * DM) + F.lane;
#pragma unroll
        for (int j = 0; j < 8; ++j) v[j] = xr[64 * j]; }
    for (int row = gw; row < SEQ; row += NGW) {
        const int rn = row + NGW < SEQ ? row + NGW : row;
        { const f32x4* xr = (const f32x4*)(xin + (size_t)rn * DM) + F.lane;
#pragma unroll
          for (int j = 0; j < 8; ++j) vn[j] = xr[64 * j]; }
        float s = 0.f;
#pragma unroll
        for (int j = 0; j < 8; ++j) s += (v[j][0] * v[j][0] + v[j][1] * v[j][1]) + (v[j][2] * v[j][2] + v[j][3] * v[j][3]);
        const float rstd = __builtin_amdgcn_rsqf(wave_sum(s) * (1.0f / DM) + EPS);
        u32x2* op = (u32x2*)(H + (size_t)row * DM) + F.lane;
#pragma unroll
        for (int j = 0; j < 8; ++j) { const f32x4 y = v[j] * rstd * gs[j] + sh[j]; u32x2 w; w.x = cvt_pk_bf16(y[0], y[1]); w.y = cvt_pk_bf16(y[2], y[3]); op[64 * j] = w; }
#pragma unroll
        for (int j = 0; j < 8; ++j) v[j] = vn[j];
    }
}

template <int W>
__device__ __forceinline__ void pool_d_item(const bf16_t* UA, bf16_t* D, int t, int g, int c8) {
    const int n = (t + 1) < W ? (t + 1) : W;
    u32x4 uw[W];
#pragma unroll
    for (int j = 0; j < W; ++j) uw[j] = *(const u32x4*)(UA + (size_t)(j < n ? t - j : t) * HALFW + c8 * 8);
    float a[8];
#pragma unroll
    for (int e = 0; e < 8; ++e) a[e] = 0.f;
#pragma unroll
    for (int j = 0; j < W; ++j) { const float wj = j < n ? 1.0f : 0.0f; const u32x4 u = uw[j];
        a[0] = fmaf(wj, bflo(u.x), a[0]); a[1] = fmaf(wj, bfhi(u.x), a[1]); a[2] = fmaf(wj, bflo(u.y), a[2]); a[3] = fmaf(wj, bfhi(u.y), a[3]);
        a[4] = fmaf(wj, bflo(u.z), a[4]); a[5] = fmaf(wj, bfhi(u.z), a[5]); a[6] = fmaf(wj, bflo(u.w), a[6]); a[7] = fmaf(wj, bfhi(u.w), a[7]); }
    const float inv = 1.0f / (float)n; const u32x4 u0 = uw[0];
    u32x4 o;
    o.x = cvt_pk_bf16(a[0] * inv - bflo(u0.x), a[1] * inv - bfhi(u0.x)); o.y = cvt_pk_bf16(a[2] * inv - bflo(u0.y), a[3] * inv - bfhi(u0.y));
    o.z = cvt_pk_bf16(a[4] * inv - bflo(u0.z), a[5] * inv - bfhi(u0.z)); o.w = cvt_pk_bf16(a[6] * inv - bflo(u0.w), a[7] * inv - bfhi(u0.w));
    *(u32x4*)(D + ((size_t)g * SEQ + t) * 256 + (c8 & 31) * 8) = o;
}
__device__ __forceinline__ void phase_pool_d(Frame& F, const bf16_t* UA, bf16_t* D) {
    const int gw = F.bid * 8 + F.wave, NGW = F.G * 8;
    for (int it = gw; it < (SEQ / 2) * 4; it += NGW) {
        const int g = it & 3, t = 2 * (it >> 2) + (F.lane >> 5), c8 = g * 32 + (F.lane & 31);
        if (g == 0) pool_d_item<2>(UA, D, t, g, c8); else if (g == 1) pool_d_item<4>(UA, D, t, g, c8); else if (g == 2) pool_d_item<8>(UA, D, t, g, c8); else pool_d_item<16>(UA, D, t, g, c8);
    }
}

__device__ __forceinline__ bool better_(float av, int ai, float bv, int bi) { return av > bv || (av == bv && ai < bi); }
__device__ __forceinline__ void top3_insert(float v, int i, float& v0, int& i0, float& v1, int& i1, float& v2, int& i2) {
    const bool b0 = better_(v, i, v0, i0), b1 = better_(v, i, v1, i1), b2 = better_(v, i, v2, i2);
    const float n2 = b1 ? v1 : (b2 ? v : v2); const int m2 = b1 ? i1 : (b2 ? i : i2);
    const float n1 = b0 ? v0 : (b1 ? v : v1); const int m1 = b0 ? i0 : (b1 ? i : i1);
    const float n0 = b0 ? v : v0; const int m0 = b0 ? i : i0;
    v0 = n0; i0 = m0; v1 = n1; i1 = m1; v2 = n2; i2 = m2;
}
__device__ __forceinline__ void phase_top3(Frame& F, const bf16_t* Q, const float* KMEAN, unsigned* cnt, unsigned* LIST, float* PARTML, float knb) {
    const int gw = F.bid * 8 + F.wave, NGW = F.G * 8, r32 = F.lane & 31, hi = F.lane >> 5;
    for (int it = gw; it < 512 * 8; it += NGW) {
        const int tt = it >> 3, h = it & 7, own = tt >> 3;
        if (own == 0) continue;
        const int t = 32 * tt + r32;
        bf16x8 qr[8];
#pragma unroll
        for (int s = 0; s < 8; ++s) qr[s] = *(const bf16x8*)(Q + ((size_t)h * SEQ + t) * HD + 16 * s + 8 * hi);
        float v0 = NEG_INF, v1 = NEG_INF, v2 = NEG_INF; int i0 = 1000, i1 = 1001, i2 = 1002;
        const int nbt = own > 32 ? 2 : 1;
        for (int bt = 0; bt < nbt; ++bt) {
            f32x16 S = {};
            const float* kp = KMEAN + ((size_t)h * 64 + 32 * bt + r32) * HD + 8 * hi;
            f32x4 ka_[8], kb_[8];
#pragma unroll
            for (int s = 0; s < 8; ++s) { ka_[s] = *(const f32x4*)(kp + 16 * s); kb_[s] = *(const f32x4*)(kp + 16 * s + 4); }
            __builtin_amdgcn_sched_barrier(0);
#pragma unroll
            for (int s = 0; s < 8; ++s) {
                const f32x4 a = ka_[s], b = kb_[s];
                u32x4 wh; wh.x = cvt_pk_bf16(a[0], a[1]); wh.y = cvt_pk_bf16(a[2], a[3]); wh.z = cvt_pk_bf16(b[0], b[1]); wh.w = cvt_pk_bf16(b[2], b[3]);
                u32x4 wl; wl.x = cvt_pk_bf16(a[0] - bflo(wh.x), a[1] - bfhi(wh.x)); wl.y = cvt_pk_bf16(a[2] - bflo(wh.y), a[3] - bfhi(wh.y));
                wl.z = cvt_pk_bf16(b[0] - bflo(wh.z), b[1] - bfhi(wh.z)); wl.w = cvt_pk_bf16(b[2] - bflo(wh.w), b[3] - bfhi(wh.w));
                S = __builtin_amdgcn_mfma_f32_32x32x16_bf16(*(bf16x8*)&wh, qr[s], S, 0, 0, 0);
                S = __builtin_amdgcn_mfma_f32_32x32x16_bf16(*(bf16x8*)&wl, qr[s], S, 0, 0, 0);
            }
#pragma unroll
            for (int r = 0; r < 16; ++r) { const int blk = 32 * bt + crow(r, hi); const float v = blk < own ? S[r] : NEG_INF; top3_insert(v, blk, v0, i0, v1, i1, v2, i2); }
        }
        { const float pv0 = __shfl_xor(v0, 32), pv1 = __shfl_xor(v1, 32), pv2 = __shfl_xor(v2, 32); const int pi0 = __shfl_xor(i0, 32), pi1 = __shfl_xor(i1, 32), pi2 = __shfl_xor(i2, 32);
          top3_insert(pv0, pi0, v0, i0, v1, i1, v2, i2); top3_insert(pv1, pi1, v0, i0, v1, i1, v2, i2); top3_insert(pv2, pi2, v0, i0, v1, i1, v2, i2); }
        float ss = 0.f;
#pragma unroll
        for (int s = 0; s < 8; ++s)
#pragma unroll
            for (int e_ = 0; e_ < 8; ++e_) { const float v = bf2f((unsigned short)qr[s][e_]); ss = fmaf(v, v, ss); }
        ss += __shfl_xor(ss, 32);
        const float rowb = sqrtf(ss) * knb, sl = exp2f(-(float)(h + 1)) / SCALE;
        if (hi == 0) {
            const int nv = own < 3 ? own : 3;
            const int idx3[3] = {i0, i1, i2};
            int tt = t; asm volatile("" : "+v"(tt));
#pragma unroll
            for (int r = 0; r < 3; ++r) if (r < nv) {
                const int ib = idx3[r], dmin = tt - (256 * ib + 255);
                if ((2.0f * rowb - sl * (float)dmin) * C2 < -48.0f) { float ne_ = -1e30f, ze_ = 0.f; asm volatile("" : "+v"(ne_), "+v"(ze_)); *(f32x2*)(PARTML + (((size_t)h * SEQ + tt) * 3 + r) * 2) = (f32x2){ne_, ze_}; }
                else { const unsigned s = atomicAdd(cnt + (h * 64 + ib) * 16, 1u); LIST[((size_t)h * 64 + ib) * SEQ + s] = ((unsigned)tt << 2) | (unsigned)r; }
            }
        }
    }
}

namespace att {
constexpr int KPITCH = 272, VPITCH = 136, KBUFB = 64 * KPITCH, VBUFB = 128 * VPITCH, BUFB = KBUFB + VBUFB;
static_assert(2 * BUFB <= RING_BYTES, "lds");
constexpr float ATT_CUT = -48.0f;
constexpr int ATT_SCR = 2 * KBUFB + 3 * VBUFB;
template <int MODE>
__device__ __forceinline__ void attn_core(LAS unsigned char* lds, const bf16_t* Kh, const bf16_t* VTh, const bf16_t* qptr, int t, int j0, int j1, int jact,
                                          float sl, const unsigned short* mrow, float knb, f32x16 (&o)[4], float& m_out, float& l_out) {
    constexpr bool DESC = (MODE == 0);
    const int tid = opaque_tid(), lane = tid & 63, r32 = lane & 31, hi = lane >> 5, wid = __builtin_amdgcn_readfirstlane(tid >> 6);
    const bool lag = (MODE != 0) && wid >= 4;
    bf16x8 qr[8];
#pragma unroll
    for (int d0 = 0; d0 < 8; ++d0) qr[d0] = *(const bf16x8*)(qptr + 16 * d0 + 8 * hi);
    float rowb = 0.f;
    if (DESC) {
        float ss = 0.f;
#pragma unroll
        for (int d0 = 0; d0 < 8; ++d0)
#pragma unroll
            for (int e = 0; e < 8; ++e) { const float v = bf2f((unsigned short)qr[d0][e]); ss = fmaf(v, v, ss); }
        ss += __shfl_xor(ss, 32);
        rowb = sqrtf(ss) * knb;
    }
#pragma unroll
    for (int d0 = 0; d0 < 4; ++d0) o[d0] = f32x16{};
    float m = -1e30f, l = 0.f;
    const int nt = j1 - j0, jfirst = DESC ? j1 - 1 : j0;
    LAS unsigned char* Kr = lds; LAS unsigned char* Vr = lds + 2 * KBUFB;
    LAS int* donef = (LAS int*)(lds + ATT_SCR);
    bf16x8 sk0, sk1, sv0, sv1;
#define LOADKV(j_) do { const bf16_t* kp_ = Kh + (size_t)(64 * (j_) + (tid >> 3)) * HD + (tid & 7) * 8; sk0 = *(const bf16x8*)kp_; sk1 = *(const bf16x8*)(kp_ + 64); \
        const bf16_t* vp_ = VTh + (size_t)(tid >> 3) * SEQ + 64 * (j_) + (tid & 7) * 8; sv0 = *(const bf16x8*)vp_; sv1 = *(const bf16x8*)(vp_ + (size_t)64 * SEQ); } while (0)
#define WRITEKV(kb_, vb_) do { LAS unsigned char* kd_ = Kr + (kb_) * KBUFB + (tid >> 3) * KPITCH + (tid & 7) * 16; *(LAS bf16x8*)kd_ = sk0; *(LAS bf16x8*)(kd_ + 128) = sk1; \
        LAS unsigned char* vd_ = Vr + (vb_) * VBUFB + (tid >> 3) * VPITCH + (tid & 7) * 16; \
        *(LAS s16x4*)vd_ = __builtin_shufflevector(sv0, sv0, 0, 1, 2, 3); *(LAS s16x4*)(vd_ + 8) = __builtin_shufflevector(sv0, sv0, 4, 5, 6, 7); \
        *(LAS s16x4*)(vd_ + 64 * VPITCH) = __builtin_shufflevector(sv1, sv1, 0, 1, 2, 3); *(LAS s16x4*)(vd_ + 64 * VPITCH + 8) = __builtin_shufflevector(sv1, sv1, 4, 5, 6, 7); } while (0)
#define PVMM(vbuf_) do { const LAS unsigned char* vb_ = Vr + (vbuf_) * VBUFB + r32 * VPITCH + hi * 8; \
        _Pragma("unroll") for (int s = 0; s < 4; ++s) { \
            _Pragma("unroll") for (int d0 = 0; d0 < 4; ++d0) { const s16x4 vl_ = *(const LAS s16x4*)(vb_ + d0 * 32 * VPITCH + s * 32), vh_ = *(const LAS s16x4*)(vb_ + d0 * 32 * VPITCH + s * 32 + 16); \
                const bf16x8 a_ = (bf16x8){vl_[0], vl_[1], vl_[2], vl_[3], vh_[0], vh_[1], vh_[2], vh_[3]}; \
                o[d0] = __builtin_amdgcn_mfma_f32_32x32x16_bf16(a_, pb[s], o[d0], 0, 0, 0); } \
            __builtin_amdgcn_sched_barrier(0); } } while (0)
    LOADKV(jfirst); WRITEKV(0, 0);
    unsigned mb0 = 0xffffu, mb1 = 0xffffu;
    if (MODE == 0) { if (jfirst <= jact) { mb0 = mrow[(size_t)(2 * jfirst) * 64]; mb1 = mrow[(size_t)(2 * jfirst + 1) * 64]; } }
    bool wdone = false, pend = false;
    bf16x8 pb[4];
    int vcur = 0;
    __syncthreads();
    for (int it = 0; it < nt; ++it) {
        const int j = DESC ? j1 - 1 - it : j0 + it, jn = DESC ? j - 1 : j + 1;
        const int vprev = vcur == 0 ? 2 : vcur - 1, vnext = vcur == 2 ? 0 : vcur + 1;
        const bool more = it + 1 < nt;
        if (more) LOADKV(jn);
        unsigned nb0 = 0xffffu, nb1 = 0xffffu;
        if (MODE == 0) { if (more && jn <= jact && !wdone) { nb0 = mrow[(size_t)(2 * jn) * 64]; nb1 = mrow[(size_t)(2 * jn + 1) * 64]; } }
        if (pend) { PVMM(vprev); pend = false; }
        if (j <= jact && !wdone) {
            f32x16 s0, s1;
            const float base = (float)(64 * j - t + 4 * hi) * sl;
#pragma unroll
            for (int r = 0; r < 16; ++r) { const int c = (r & 3) + 8 * (r >> 2); s0[r] = fmaf(sl, (float)c, base); s1[r] = fmaf(sl, (float)(c + 32), base); }
            const LAS unsigned char* kb = Kr + (it & 1) * KBUFB + r32 * KPITCH + hi * 16;
#pragma unroll
            for (int g = 0; g < 2; ++g) {
                bf16x8 fa[4], fb[4];
#pragma unroll
                for (int d = 0; d < 4; ++d) { fa[d] = *(const LAS bf16x8*)(kb + (4 * g + d) * 32); fb[d] = *(const LAS bf16x8*)(kb + 32 * KPITCH + (4 * g + d) * 32); }
                __builtin_amdgcn_sched_barrier(0);
#pragma unroll
                for (int d = 0; d < 4; ++d) {
                    s0 = __builtin_amdgcn_mfma_f32_32x32x16_bf16(fa[d], qr[4 * g + d], s0, 0, 0, 0);
                    s1 = __builtin_amdgcn_mfma_f32_32x32x16_bf16(fb[d], qr[4 * g + d], s1, 0, 0, 0);
                }
                __builtin_amdgcn_sched_barrier(0);
            }
            if (MODE == 0) {
#pragma unroll
                for (int r = 0; r < 16; ++r) { if (!((mb0 >> r) & 1u)) s0[r] = NEG_INF; if (!((mb1 >> r) & 1u)) s1[r] = NEG_INF; }
            }
            if (MODE == 2) {
                const int kp0 = 64 * j + 4 * hi;
#pragma unroll
                for (int r = 0; r < 16; ++r) { const int c = (r & 3) + 8 * (r >> 2); if (kp0 + c > t) s0[r] = NEG_INF; if (kp0 + c + 32 > t) s1[r] = NEG_INF; }
            }
            float tm = fmaxf(s0[0], s1[0]);
#pragma unroll
            for (int r = 1; r < 16; ++r) tm = fmaxf(tm, fmaxf(s0[r], s1[r]));
            tm = fmaxf(tm, __shfl_xor(tm, 32));
            const float mn = fmaxf(m, tm), alpha = fast_exp2((m - mn) * C2), mc = -mn * C2;
            m = mn;
            float ps = 0.f;
#pragma unroll
            for (int r = 0; r < 16; ++r) { s0[r] = fast_exp2(fmaf(s0[r], C2, mc)); s1[r] = fast_exp2(fmaf(s1[r], C2, mc)); ps += s0[r] + s1[r]; }
            ps += __shfl_xor(ps, 32);
            l = l * alpha + ps;
            if (__any(alpha != 1.0f)) {
#pragma unroll
                for (int d0 = 0; d0 < 4; ++d0)
#pragma unroll
                    for (int r = 0; r < 16; ++r) o[d0][r] *= alpha;
            }
            u32x4 pw;
            pw.x = cvt_pk_bf16(s0[0], s0[1]); pw.y = cvt_pk_bf16(s0[2], s0[3]); pw.z = cvt_pk_bf16(s0[4], s0[5]); pw.w = cvt_pk_bf16(s0[6], s0[7]); pb[0] = *(bf16x8*)&pw;
            pw.x = cvt_pk_bf16(s0[8], s0[9]); pw.y = cvt_pk_bf16(s0[10], s0[11]); pw.z = cvt_pk_bf16(s0[12], s0[13]); pw.w = cvt_pk_bf16(s0[14], s0[15]); pb[1] = *(bf16x8*)&pw;
            pw.x = cvt_pk_bf16(s1[0], s1[1]); pw.y = cvt_pk_bf16(s1[2], s1[3]); pw.z = cvt_pk_bf16(s1[4], s1[5]); pw.w = cvt_pk_bf16(s1[6], s1[7]); pb[2] = *(bf16x8*)&pw;
            pw.x = cvt_pk_bf16(s1[8], s1[9]); pw.y = cvt_pk_bf16(s1[10], s1[11]); pw.z = cvt_pk_bf16(s1[12], s1[13]); pw.w = cvt_pk_bf16(s1[14], s1[15]); pb[3] = *(bf16x8*)&pw;
            if (lag) pend = true; else PVMM(vcur);
            if (DESC) {
                const float xmax = rowb + sl * (float)(64 * j - 1 - t);
                wdone = __all(m > -1e29f && (xmax - m) * C2 < ATT_CUT) != 0;
            }
        }
        mb0 = nb0; mb1 = nb1;
        if (more) WRITEKV((it & 1) ^ 1, vnext);
        if (DESC) { if (lane == 0) donef[(it & 1) * 8 + wid] = wdone ? 1 : 0; }
        __syncthreads();
        vcur = vnext;
        if (DESC) { const LAS int* df = donef + (it & 1) * 8; if ((df[0] & df[1] & df[2] & df[3] & df[4] & df[5] & df[6] & df[7]) != 0) break; }
    }
    if (pend) { const int vprev = vcur == 0 ? 2 : vcur - 1; PVMM(vprev); }
    __syncthreads();
#undef LOADKV
#undef WRITEKV
#undef PVMM
    m_out = m; l_out = l;
}

constexpr int STG_OFF = ATT_SCR + 1024, STG_PITCH = 272, STG_WAVE = 32 * STG_PITCH, STG_END = STG_OFF + 8 * STG_WAVE;
static_assert(STG_END <= 158720, "lds");
#define STG_MEM() asm volatile("" ::: "memory")
__device__ __forceinline__ void stg_put_lines(LAS unsigned char* st, int lane, const u32x4 (&v)[8]) {
#pragma unroll
    for (int k = 0; k < 8; ++k) *(LAS u32x4*)(st + ((lane >> 3) + 8 * (k >> 1)) * STG_PITCH + 128 * (k & 1) + 16 * (lane & 7)) = v[k];
}
__device__ __forceinline__ void stg_get_lines(const LAS unsigned char* st, int lane, u32x4 (&v)[8]) {
#pragma unroll
    for (int k = 0; k < 8; ++k) v[k] = *(const LAS u32x4*)(st + ((lane >> 3) + 8 * (k >> 1)) * STG_PITCH + 128 * (k & 1) + 16 * (lane & 7));
}
__device__ __forceinline__ void stg_put_frag(LAS unsigned char* st, int r32, int hi, const u32x2 (&f)[16]) {
#pragma unroll
    for (int i = 0; i < 16; ++i) *(LAS u32x2*)(st + r32 * STG_PITCH + 64 * (i >> 2) + 16 * (i & 3) + 8 * hi) = f[i];
}
__device__ __forceinline__ void stg_get_frag(const LAS unsigned char* st, int r32, int hi, u32x2 (&f)[16]) {
#pragma unroll
    for (int i = 0; i < 16; ++i) f[i] = *(const LAS u32x2*)(st + r32 * STG_PITCH + 64 * (i >> 2) + 16 * (i & 3) + 8 * hi);
}
__device__ __forceinline__ void dsa_unit(LAS unsigned char* lds, int h, int qb, int j0, int j1, int slot, const bf16_t* Q, const bf16_t* K, const bf16_t* VT, const unsigned short* MASK, const bf16_t* SG, bf16_t* YG,
                                         bf16_t* PARTO, float* PARTML, float knb) {
    const int tid = opaque_tid(), wid = __builtin_amdgcn_readfirstlane(tid >> 6), lane = tid & 63, r32 = lane & 31, hi = lane >> 5;
    const int qt = 8 * qb + wid, t = 256 * qb + 32 * wid + r32;
    const float sl = exp2f(-(float)(h + 1)) / SCALE;
    f32x16 o[4]; float m, l;
    attn_core<0>(lds, K + (size_t)h * SEQ * HD, VT + (size_t)h * HD * SEQ, Q + ((size_t)h * SEQ + t) * HD, t, j0, j1, 4 * qb + (wid >> 1), sl,
                 MASK + ((size_t)qt * 512) * 64 + lane, knb, o, m, l);
    int te = t; asm volatile("" : "+v"(te));
    const float inv = l > 0.f ? 1.0f / l : 0.f;
    LAS unsigned char* st = lds + STG_OFF + wid * STG_WAVE;
    const int tw = 256 * qb + 32 * wid;
    if (slot < 0) {
        u32x4 ln[8];
#pragma unroll
        for (int k = 0; k < 8; ++k) ln[k] = *(const u32x4*)(SG + (size_t)(tw + (lane >> 3) + 8 * (k >> 1)) * DM + h * HD + 64 * (k & 1) + 8 * (lane & 7));
        stg_put_lines(st, lane, ln); STG_MEM();
        u32x2 f[16]; stg_get_frag(st, r32, hi, f); STG_MEM();
#pragma unroll
        for (int i = 0; i < 16; ++i) { const int d0 = i >> 2, r4 = i & 3; const u32x2 g = f[i];
            u32x2 w; w.x = cvt_pk_bf16(o[d0][4 * r4] * inv * bflo(g.x), o[d0][4 * r4 + 1] * inv * bfhi(g.x));
            w.y = cvt_pk_bf16(o[d0][4 * r4 + 2] * inv * bflo(g.y), o[d0][4 * r4 + 3] * inv * bfhi(g.y)); f[i] = w; }
        stg_put_frag(st, r32, hi, f); STG_MEM();
        stg_get_lines(st, lane, ln); STG_MEM();
#pragma unroll
        for (int k = 0; k < 8; ++k) *(u32x4*)(YG + (size_t)(tw + (lane >> 3) + 8 * (k >> 1)) * DM + h * HD + 64 * (k & 1) + 8 * (lane & 7)) = ln[k];
    } else {
        const size_t pw = (size_t)slot * 256 + 32 * wid;
        u32x2 f[16];
#pragma unroll
        for (int i = 0; i < 16; ++i) { const int d0 = i >> 2, r4 = i & 3;
            f[i].x = cvt_pk_bf16(o[d0][4 * r4] * inv, o[d0][4 * r4 + 1] * inv); f[i].y = cvt_pk_bf16(o[d0][4 * r4 + 2] * inv, o[d0][4 * r4 + 3] * inv); }
        stg_put_frag(st, r32, hi, f); STG_MEM();
        u32x4 ln[8]; stg_get_lines(st, lane, ln); STG_MEM();
#pragma unroll
        for (int k = 0; k < 8; ++k) *(u32x4*)(PARTO + (pw + (lane >> 3) + 8 * (k >> 1)) * HD + 64 * (k & 1) + 8 * (lane & 7)) = ln[k];
        if (hi == 0) *(f32x2*)(PARTML + (pw + r32) * 2) = (f32x2){m, l};
    }
}
__device__ __forceinline__ void dsa_merge(int bid, int G, int tid, const bf16_t* PARTO, const float* PARTML, const bf16_t* SG, bf16_t* YG) {
    for (int idx = bid * 512 + tid; idx < 48 * 256 * 16; idx += G * 512) {
        const int k = idx >> 12, row = (idx >> 4) & 255, dc = idx & 15;
        const int qb = 63 - k, t = 256 * qb + row, nch = (4 * qb + 4 + 63) >> 6;
        float pm[4], pl[4]; float M = -1e30f;
#pragma unroll
        for (int c = 0; c < 4; ++c) { pm[c] = -1e30f; pl[c] = 0.f; if (c < nch) { const f32x2 v = *(const f32x2*)(PARTML + ((size_t)(4 * k + c) * 256 + row) * 2); pm[c] = v[0]; pl[c] = v[1]; M = fmaxf(M, pm[c]); } }
        float acc[8] = {0.f, 0.f, 0.f, 0.f, 0.f, 0.f, 0.f, 0.f}; float den = 0.f;
#pragma unroll
        for (int c = 0; c < 4; ++c) if (c < nch && pl[c] > 0.f) {
            const float w = pl[c] * fast_exp2((pm[c] - M) * C2); den += w;
            const u32x4 x = *(const u32x4*)(PARTO + ((size_t)(4 * k + c) * 256 + row) * HD + dc * 8);
            acc[0] = fmaf(w, bflo(x.x), acc[0]); acc[1] = fmaf(w, bfhi(x.x), acc[1]); acc[2] = fmaf(w, bflo(x.y), acc[2]); acc[3] = fmaf(w, bfhi(x.y), acc[3]);
            acc[4] = fmaf(w, bflo(x.z), acc[4]); acc[5] = fmaf(w, bfhi(x.z), acc[5]); acc[6] = fmaf(w, bflo(x.w), acc[6]); acc[7] = fmaf(w, bfhi(x.w), acc[7]);
        }
        const float inv = 1.0f / den;
        const size_t off = (size_t)t * DM + 7 * HD + dc * 8;
        const u32x4 g = *(const u32x4*)(SG + off);
        u32x4 r;
        r.x = cvt_pk_bf16(acc[0] * inv * bflo(g.x), acc[1] * inv * bfhi(g.x)); r.y = cvt_pk_bf16(acc[2] * inv * bflo(g.y), acc[3] * inv * bfhi(g.y));
        r.z = cvt_pk_bf16(acc[4] * inv * bflo(g.z), acc[5] * inv * bfhi(g.z)); r.w = cvt_pk_bf16(acc[6] * inv * bflo(g.w), acc[7] * inv * bfhi(g.w));
        *(u32x4*)(YG + off) = r;
    }
}
__device__ __forceinline__ void moba_sel_unit(LAS unsigned char* lds, int h, int b, int c, int cnt, const unsigned* LIST, const bf16_t* Q, const bf16_t* K, const bf16_t* VT, bf16_t* PARTO, float* PARTML) {
    const int tid = opaque_tid(), wid = __builtin_amdgcn_readfirstlane(tid >> 6), lane = tid & 63, r32 = lane & 31, hi = lane >> 5;
    const int i = 256 * c + 32 * wid + r32; const bool valid = i < cnt;
    const unsigned e = LIST[((size_t)h * 64 + b) * SEQ + (valid ? i : cnt - 1)];
    const int t = (int)(e >> 2), rank = (int)(e & 3u);
    const float sl = exp2f(-(float)(h + 1)) / SCALE;
    f32x16 o[4]; float m, l;
    attn_core<1>(lds, K + (size_t)h * SEQ * HD, VT + (size_t)h * HD * SEQ, Q + ((size_t)h * SEQ + t) * HD, t, 4 * b, 4 * b + 4, (256 * c + 32 * wid < cnt) ? 4 * b + 3 : -1, sl, nullptr, 0.f, o, m, l);
    int te = t; asm volatile("" : "+v"(te));
    {
        const float inv = 1.0f / l; const unsigned pr = (unsigned)(((size_t)h * SEQ + te) * 3 + rank);
        LAS unsigned char* st = lds + STG_OFF + wid * STG_WAVE;
        u32x2 f[16];
#pragma unroll
        for (int i = 0; i < 16; ++i) { const int d0 = i >> 2, r4 = i & 3;
            f[i].x = cvt_pk_bf16(o[d0][4 * r4] * inv, o[d0][4 * r4 + 1] * inv); f[i].y = cvt_pk_bf16(o[d0][4 * r4 + 2] * inv, o[d0][4 * r4 + 3] * inv); }
        stg_put_frag(st, r32, hi, f);
        if (hi == 0) *(LAS unsigned*)(st + r32 * STG_PITCH + 256) = valid ? pr : 0xffffffffu;
        STG_MEM();
        u32x4 ln[8]; stg_get_lines(st, lane, ln);
        unsigned prow[4];
#pragma unroll
        for (int i = 0; i < 4; ++i) prow[i] = *(const LAS unsigned*)(st + ((lane >> 3) + 8 * i) * STG_PITCH + 256);
        STG_MEM();
#pragma unroll
        for (int k = 0; k < 8; ++k) if (prow[k >> 1] != 0xffffffffu) *(u32x4*)(PARTO + (size_t)prow[k >> 1] * HD + 64 * (k & 1) + 8 * (lane & 7)) = ln[k];
        if (valid && hi == 0) *(f32x2*)(PARTML + (size_t)pr * 2) = (f32x2){m, l};
    }
}
__device__ __forceinline__ void moba_own_unit(LAS unsigned char* lds, int h, int b, const bf16_t* Q, const bf16_t* K, const bf16_t* VT, const bf16_t* PARTO, const float* PARTML, const bf16_t* SG, bf16_t* YG) {
    const int tid = opaque_tid(), wid = __builtin_amdgcn_readfirstlane(tid >> 6), lane = tid & 63, r32 = lane & 31, hi = lane >> 5;
    const int t = 256 * b + 32 * wid + r32;
    const float sl = exp2f(-(float)(h + 1)) / SCALE;
    f32x16 o[4]; float m, l;
    attn_core<2>(lds, K + (size_t)h * SEQ * HD, VT + (size_t)h * HD * SEQ, Q + ((size_t)h * SEQ + t) * HD, t, 4 * b, 4 * b + 4, 4 * b + (wid >> 1), sl, nullptr, 0.f, o, m, l);
    int te = t; asm volatile("" : "+v"(te));
    const int nv = b < 3 ? b : 3; const size_t pr = ((size_t)h * SEQ + te) * 3;
    float pm[3], pl[3]; float M = m;
#pragma unroll
    for (int r = 0; r < 3; ++r) { pm[r] = -1e30f; pl[r] = 0.f; if (r < nv) { const f32x2 v = *(const f32x2*)(PARTML + (pr + r) * 2); pm[r] = v[0]; pl[r] = v[1]; M = fmaxf(M, pm[r]); } }
    const float wo = fast_exp2((m - M) * C2);
    float wr_[3]; float den = l * wo;
#pragma unroll
    for (int r = 0; r < 3; ++r) { wr_[r] = (r < nv) ? pl[r] * fast_exp2((pm[r] - M) * C2) : 0.f; den += wr_[r]; }
    const float inv = 1.0f / den;
    LAS unsigned char* st = lds + STG_OFF + wid * STG_WAVE;
    const int tw = 256 * b + 32 * wid;
    u32x4 lp[3][8], lg[8];
#pragma unroll
    for (int r = 0; r < 3; ++r) if (r < nv) {
#pragma unroll
        for (int k = 0; k < 8; ++k) lp[r][k] = *(const u32x4*)(PARTO + (((size_t)h * SEQ + tw + (lane >> 3) + 8 * (k >> 1)) * 3 + r) * HD + 64 * (k & 1) + 8 * (lane & 7));
    }
#pragma unroll
    for (int k = 0; k < 8; ++k) lg[k] = *(const u32x4*)(SG + (size_t)(tw + (lane >> 3) + 8 * (k >> 1)) * DM + HALFW + h * HD + 64 * (k & 1) + 8 * (lane & 7));
#pragma unroll
    for (int d0 = 0; d0 < 4; ++d0)
#pragma unroll
        for (int i = 0; i < 16; ++i) o[d0][i] *= wo;
    u32x2 f[16];
#pragma unroll
    for (int r = 0; r < 3; ++r) if (r < nv) {
        stg_put_lines(st, lane, lp[r]); STG_MEM();
        stg_get_frag(st, r32, hi, f); STG_MEM();
        const bool use = pl[r] > 0.f;
#pragma unroll
        for (int i = 0; i < 16; ++i) { const int d0 = i >> 2, r4 = i & 3; const u32x2 p = use ? f[i] : (u32x2){0u, 0u};
            o[d0][4 * r4] = fmaf(wr_[r], bflo(p.x), o[d0][4 * r4]); o[d0][4 * r4 + 1] = fmaf(wr_[r], bfhi(p.x), o[d0][4 * r4 + 1]);
            o[d0][4 * r4 + 2] = fmaf(wr_[r], bflo(p.y), o[d0][4 * r4 + 2]); o[d0][4 * r4 + 3] = fmaf(wr_[r], bfhi(p.y), o[d0][4 * r4 + 3]); }
    }
    stg_put_lines(st, lane, lg); STG_MEM();
    stg_get_frag(st, r32, hi, f); STG_MEM();
#pragma unroll
    for (int i = 0; i < 16; ++i) { const int d0 = i >> 2, r4 = i & 3; const u32x2 g = f[i];
        u32x2 w; w.x = cvt_pk_bf16(o[d0][4 * r4] * inv * bflo(g.x), o[d0][4 * r4 + 1] * inv * bfhi(g.x)); w.y = cvt_pk_bf16(o[d0][4 * r4 + 2] * inv * bflo(g.y), o[d0][4 * r4 + 3] * inv * bfhi(g.y)); f[i] = w; }
    stg_put_frag(st, r32, hi, f); STG_MEM();
    stg_get_lines(st, lane, lg); STG_MEM();
#pragma unroll
    for (int k = 0; k < 8; ++k) *(u32x4*)(YG + (size_t)(tw + (lane >> 3) + 8 * (k >> 1)) * DM + HALFW + h * HD + 64 * (k & 1) + 8 * (lane & 7)) = lg[k];
}
}

namespace dsa {
constexpr int NB = 512, CAP = 256;
constexpr int QPITCH = 1296;
constexpr int HSTR = 513;
__device__ __forceinline__ void fold_abs(f32x16& sc, const f32x16& a, float w) {
#pragma unroll
    for (int r = 0; r < 16; ++r) { float t = fmaf(w, __builtin_fabsf(a[r]), sc[r]); asm volatile("" : "+v"(t)); sc[r] = t; }
}
__device__ __forceinline__ void scores2(f32x16& sc0, f32x16& sc1, const bf16x8 (&ka)[4], const bf16x8 (&kb)[4], const LAS unsigned char* qrow, const float (&w)[8]) {
    bf16x8 b0[4], b1[4];
#define DSA_LDB(dst, off) do { _Pragma("unroll") for (int s_ = 0; s_ < 4; ++s_) dst[s_] = *(const LAS bf16x8*)(qrow + ((off) + 16 * s_) * 2); } while (0)
#define DSA_MM(c0, c1, bb) do { __builtin_amdgcn_s_setprio(1); _Pragma("unroll") for (int s_ = 0; s_ < 4; ++s_) { c0 = __builtin_amdgcn_mfma_f32_32x32x16_bf16(ka[s_], bb[s_], c0, 0, 0, 0); c1 = __builtin_amdgcn_mfma_f32_32x32x16_bf16(kb[s_], bb[s_], c1, 0, 0, 0); } __builtin_amdgcn_s_setprio(0); } while (0)
#define DSA_SB __builtin_amdgcn_sched_barrier(0)
    sc0 = f32x16{}; sc1 = f32x16{};
    DSA_LDB(b0, 512); DSA_LDB(b1, 0); DSA_SB;
    DSA_MM(sc0, sc1, b0); DSA_SB;
#define DSA_HEAD(h, cur, nxt) do { f32x16 a0 = {}, a1 = {}; if ((h) < 7) DSA_LDB(nxt, 64 * ((h) + 1)); DSA_SB; DSA_MM(a0, a1, cur); fold_abs(sc0, a0, w[h]); fold_abs(sc1, a1, w[h]); DSA_SB; } while (0)
    DSA_HEAD(0, b1, b0); DSA_HEAD(1, b0, b1); DSA_HEAD(2, b1, b0); DSA_HEAD(3, b0, b1); DSA_HEAD(4, b1, b0); DSA_HEAD(5, b0, b1); DSA_HEAD(6, b1, b0); DSA_HEAD(7, b0, b1);
#undef DSA_HEAD
#undef DSA_SB
#undef DSA_MM
#undef DSA_LDB
}
__device__ __forceinline__ void load_ka(bf16x8 (&ka)[4], const bf16_t* KI, int kt, int r32, int hi) {
    const bf16_t* kp = KI + (size_t)(32 * kt + r32) * 64 + 8 * hi;
#pragma unroll
    for (int s = 0; s < 4; ++s) ka[s] = *(const bf16x8*)(kp + 16 * s);
}
__device__ __forceinline__ int bin0f(float sc, int kofs) {
    const int b = __float_as_int(sc), kk = (b >> 19) & 0xFFF; int p = kk + kofs; p = p < 256 ? 256 : (p > NB - 1 ? NB - 1 : p); return p ^ ((b >> 31) & (NB - 1)); }
__device__ __forceinline__ int binf(float sc, float lo, float inv) { int b = (int)fmaf(sc, inv, -lo * inv); return b < 0 ? 0 : (b > NB - 1 ? NB - 1 : b); }
__device__ __forceinline__ void select_unit(LAS unsigned char* lds, int qt, const bf16_t* QI, const float* WI, const bf16_t* KI, float kib, unsigned short* MASK) {
    const int tid = opaque_tid(), wid = __builtin_amdgcn_readfirstlane(tid >> 6), lane = tid & 63, r32 = lane & 31, hi = lane >> 5;
    LAS unsigned* hist = (LAS unsigned*)lds;
    LAS float* cs = (LAS float*)lds; LAS unsigned short* ck = (LAS unsigned short*)(lds + 32768);
    LAS unsigned short* bits16 = (LAS unsigned short*)(lds + 49152); LAS unsigned* bits32 = (LAS unsigned*)(lds + 49152);
    LAS int* Tq = (LAS int*)(lds + 114688);
    LAS float* loq = (LAS float*)(Tq + 96);
    LAS float* invq = loq + 96;
    LAS int* abv = (LAS int*)(invq + 96);
    LAS int* needv = abv + 32; LAS int* donev = needv + 32; LAS int* Lq = donev + 32; LAS unsigned* ccnt = (LAS unsigned*)(Lq + 32); LAS int* KBq = (LAS int*)(ccnt + 32); LAS int* mode1 = KBq + 32; LAS int* flag = mode1 + 32;
    const int t = 32 * qt + r32;
    LAS unsigned char* qlds = lds + 117760;
    { const int row = tid >> 4, ch = tid & 15;
      bf16x8 qv[4];
#pragma unroll
      for (int i = 0; i < 4; ++i) qv[i] = *(const bf16x8*)(QI + (size_t)(32 * qt + row) * 512 + (ch * 4 + i) * 8);
      __builtin_amdgcn_sched_barrier(0);
#pragma unroll
      for (int i = 0; i < 4; ++i) *(LAS bf16x8*)(qlds + row * QPITCH + (ch * 4 + i) * 16) = qv[i]; }
    __syncthreads();
    const LAS unsigned char* qrow = qlds + r32 * QPITCH + hi * 16;
    float w[8];
    float bsum = 0.f;
    const f32x4 wia = *(const f32x4*)(WI + (size_t)t * 8), wib = *(const f32x4*)(WI + (size_t)t * 8 + 4);
#pragma unroll
    for (int h = 0; h < 8; ++h) {
        float ss = 0.f;
#pragma unroll
        for (int s = 0; s < 4; ++s) { const bf16x8 q8 = *(const LAS bf16x8*)(qrow + (64 * h + 16 * s) * 2);
#pragma unroll
            for (int e = 0; e < 8; ++e) { const float v = bf2f((unsigned short)q8[e]); ss = fmaf(v, v, ss); } }
        ss += __shfl_xor(ss, 32);
        w[h] = (h < 4 ? wia[h & 3] : wib[h & 3]) * 0.0625f;
        bsum += fabsf(w[h]) * sqrtf(ss);
    }
    bsum *= 2.0f;
    {
        const int q = tid >> 4, d0 = (tid & 15) * 4;
        float wq[8];
        { const f32x4 qa = *(const f32x4*)(WI + (size_t)(32 * qt + q) * 8), qb = *(const f32x4*)(WI + (size_t)(32 * qt + q) * 8 + 4);
#pragma unroll
          for (int h = 0; h < 8; ++h) wq[h] = (h < 4 ? qa[h & 3] : qb[h & 3]) * 0.0625f; }
        float c4[4] = {0.f, 0.f, 0.f, 0.f};
#pragma unroll
        for (int h = 0; h < 8; ++h) { const u32x2 v = *(const LAS u32x2*)(qlds + q * QPITCH + (64 * h + d0) * 2);
            c4[0] = fmaf(wq[h], bflo(v.x), c4[0]); c4[1] = fmaf(wq[h], bfhi(v.x), c4[1]); c4[2] = fmaf(wq[h], bflo(v.y), c4[2]); c4[3] = fmaf(wq[h], bfhi(v.y), c4[3]); }
        u32x2 hh, ll; hh.x = cvt_pk_bf16(c4[0], c4[1]); hh.y = cvt_pk_bf16(c4[2], c4[3]);
        ll.x = cvt_pk_bf16(c4[0] - bflo(hh.x), c4[1] - bfhi(hh.x)); ll.y = cvt_pk_bf16(c4[2] - bflo(hh.y), c4[3] - bfhi(hh.y));
        *(LAS u32x2*)(qlds + q * QPITCH + (512 + d0) * 2) = hh; *(LAS u32x2*)(qlds + q * QPITCH + (576 + d0) * 2) = ll;
    }
#ifndef BSCALE
#define BSCALE 1.0f
#endif
#ifdef KIBCONST
    kib = KIBCONST;
#endif
    { const float Bt = (bsum * kib * 1.02f + 1e-30f) * BSCALE;
      if (wid == 0 && hi == 0) { KBq[r32] = (__float_as_int(Bt) >> 19) + 1; mode1[r32] = 0; loq[r32] = 0.f; invq[r32] = 0.f; abv[r32] = 0; donev[r32] = 0; Lq[r32] = 0; Tq[r32] = -1; needv[r32] = 0; }
      if (tid < 3) flag[tid] = 0; }
    __syncthreads();
    for (int lvl = 0; lvl < 3; ++lvl) {
        for (int i = tid; i < 32 * HSTR; i += 512) hist[i] = 0u;
        __syncthreads();
        const float lo1 = loq[32 + r32], in1 = invq[32 + r32], lo2 = loq[64 + r32], in2 = invq[64 + r32];
        const int T0 = Tq[r32], T1 = Tq[32 + r32], mydone = donev[r32], kbq_ = KBq[r32], kofs = 512 - kbq_;
#ifndef REPA
#define REPA 0
#endif
        int dummy_ = 0;
        for (int repa = 0; repa <= REPA; ++repa) {
        const unsigned addv = repa == 0 ? 1u : 0u;
        bf16x8 ka[4], kb[4], kn[4], knb[4];
        if (2 * wid <= qt) { load_ka(ka, KI, 2 * wid, r32, hi); load_ka(kb, KI, 2 * wid + 1, r32, hi); }
        for (int kt = 2 * wid; kt <= qt; kt += 16) {
            asm volatile("" : "+v"(ka[0]), "+v"(ka[1]), "+v"(ka[2]), "+v"(ka[3]), "+v"(kb[0]), "+v"(kb[1]), "+v"(kb[2]), "+v"(kb[3]));
            if (kt + 16 <= qt) { load_ka(kn, KI, kt + 16, r32, hi); load_ka(knb, KI, kt + 17, r32, hi); }
            f32x16 sc0, sc1;
            scores2(sc0, sc1, ka, kb, qrow, w);
#pragma unroll
            for (int s = 0; s < 4; ++s) { ka[s] = kn[s]; kb[s] = knb[s]; }
            if (lvl == 0 && kt + 1 < qt) {
#ifdef PROBE_NOATOM
                if (repa > 0) {
#pragma unroll
                    for (int r = 0; r < 16; ++r) { dummy_ += bin0f(sc0[r], kofs) + bin0f(sc1[r], kofs); }
                } else
#endif
                {
#pragma unroll
                for (int r = 0; r < 16; ++r) { const int bin = bin0f(sc0[r], kofs); __hip_atomic_fetch_add(hist + r32 * HSTR + bin, addv, __ATOMIC_RELAXED, __HIP_MEMORY_SCOPE_WORKGROUP); }
#pragma unroll
                for (int r = 0; r < 16; ++r) { const int bin = bin0f(sc1[r], kofs); __hip_atomic_fetch_add(hist + r32 * HSTR + bin, addv, __ATOMIC_RELAXED, __HIP_MEMORY_SCOPE_WORKGROUP); }
                }
            } else {
#pragma unroll
                for (int half = 0; half < 2; ++half)
#pragma unroll
                for (int r = 0; r < 16; ++r) {
                    const float v = half ? sc1[r] : sc0[r];
                    const int kp = 32 * (kt + half) + crow(r, hi);
                    bool mem = (kp <= t) && (mydone == 0);
                    const int b0 = bin0f(v, kofs), b1 = binf(v, lo1, in1);
                    if (lvl > 0) mem = mem && (b0 == T0);
                    if (lvl > 1) mem = mem && (b1 == T1);
                    if (mem) { const int bin = lvl == 0 ? b0 : (lvl == 1 ? b1 : binf(v, lo2, in2)); __hip_atomic_fetch_add(hist + r32 * HSTR + bin, addv, __ATOMIC_RELAXED, __HIP_MEMORY_SCOPE_WORKGROUP); }
                }
            }
        }
        }
        if (dummy_ == 0x7fffffff) hist[0] = 1u;
        __syncthreads();
        for (int qq = 0; qq < 4; ++qq) {
            const int q = 4 * wid + qq;
            if (donev[q] != 0) continue;
            const unsigned target = (unsigned)(256 - abv[q]);
            unsigned c[8]; unsigned tot = 0;
#pragma unroll
            for (int i = 0; i < 8; ++i) { c[i] = hist[q * HSTR + 8 * lane + i]; tot += c[i]; }
            unsigned suf = tot;
#pragma unroll
            for (int off = 1; off < 64; off <<= 1) { const unsigned v = __shfl_down(suf, off); if (lane + off < 64) suf += v; }
            const unsigned long long bal = __ballot(suf >= target);
            if (bal == 0ull) { if (lane == 0) { Tq[lvl * 32 + q] = -1; needv[q] = 0; donev[q] = 1; Lq[q] = lvl; } }
            else {
                const int Lc = 63 - __builtin_clzll(bal);
                if (lane == Lc) {
                    unsigned above = suf - tot; int T = 8 * lane; int nd = 0; unsigned cand = 0;
#pragma unroll
                    for (int b = 7; b >= 0; --b) { if (nd == 0) { if (above + c[b] >= target) { T = 8 * lane + b; nd = (int)(target - above); cand = c[b]; } else above += c[b]; } }
                    Tq[lvl * 32 + q] = T; needv[q] = nd; abv[q] = 256 - nd;
#ifdef PROBE_NOREFINE
                    if (cand > (unsigned)CAP) { Tq[lvl * 32 + q] = T - 1; needv[q] = 0; }
                    if (true) { donev[q] = 1; Lq[q] = lvl; }
#else
                    if (cand <= (unsigned)CAP || lvl == 2) { donev[q] = 1; Lq[q] = lvl; }
#endif
                    else { const int kbq = KBq[q];
                           if (lvl == 0) { float e0, e1; const int kbp = kbq - 256;
                               if (T >= 256) { const int kk = T - 256 + kbp; e0 = (T == 256) ? 0.f : __int_as_float(kk << 19); e1 = __int_as_float((kk + 1) << 19); }
                               else { const int kk = 255 - T + kbp; e0 = -__int_as_float((kk + 1) << 19); e1 = (T == 255) ? 0.f : -__int_as_float(kk << 19); }
                               loq[32 + q] = e0; invq[32 + q] = (float)NB / (e1 - e0);
                           } else { const float lo = loq[32 + q], in = invq[32 + q]; loq[64 + q] = lo + (float)T / in; invq[64 + q] = in * (float)NB; }
                           flag[lvl] = 1; }
                }
            }
        }
        __syncthreads();
        if (flag[lvl] == 0) break;
    }
    if (tid < 32) ccnt[tid] = 0u;
    __syncthreads();
    {
        const float lo1 = loq[32 + r32], in1 = invq[32 + r32], lo2 = loq[64 + r32], in2 = invq[64 + r32];
        const int T0 = Tq[r32], T1 = Tq[32 + r32], T2 = Tq[64 + r32], L = Lq[r32], kbq_ = KBq[r32], kofs = 512 - kbq_;
        const bool fast = (flag[0] == 0);
        float thA, thB; bool centre = (T0 == 255 || T0 == 256);
        if (T0 < 0) { thA = NEG_INF; thB = NEG_INF; }
        else if (T0 >= 257) { thA = (T0 == 511) ? __builtin_inff() : __int_as_float((T0 + 1 - kofs) << 19); thB = __int_as_float((T0 - kofs) << 19); }
        else { const unsigned M1 = (unsigned)(511 - T0 - kofs) << 19;
               thA = __uint_as_float((0x80000000u | M1) - 1u); thB = (T0 == 0) ? __uint_as_float(0xFF7FFFFFu) : __uint_as_float((0x80000000u | (M1 + (1u << 19))) - 1u); }
        { const int kkE = T0 >= 257 ? T0 - kofs : 511 - T0 - kofs; if (T0 >= 0 && (kkE < 1 || kkE > 4078)) centre = true; }
        const bool fast2 = fast && !__any(centre);
        bf16x8 ka[4], kb[4], kn[4], knb[4];
        if (2 * wid <= qt) { load_ka(ka, KI, 2 * wid, r32, hi); load_ka(kb, KI, 2 * wid + 1, r32, hi); }
        for (int kt = 2 * wid; kt <= qt; kt += 16) {
            asm volatile("" : "+v"(ka[0]), "+v"(ka[1]), "+v"(ka[2]), "+v"(ka[3]), "+v"(kb[0]), "+v"(kb[1]), "+v"(kb[2]), "+v"(kb[3]));
            if (kt + 16 <= qt) { load_ka(kn, KI, kt + 16, r32, hi); load_ka(knb, KI, kt + 17, r32, hi); }
            f32x16 sc0, sc1;
            scores2(sc0, sc1, ka, kb, qrow, w);
#pragma unroll
            for (int s = 0; s < 4; ++s) { ka[s] = kn[s]; kb[s] = knb[s]; }
            unsigned bits0 = 0u, bits1 = 0u;
            if (fast2 && kt + 1 < qt) {
#pragma unroll
                for (int half = 0; half < 2; ++half) {
                    unsigned bv = 0u;
#pragma unroll
                    for (int r = 15; r >= 0; --r) {
                        const float v = half ? sc1[r] : sc0[r];
                        asm volatile("v_cmp_ge_f32_e32 vcc, %1, %2\n\ts_nop 1\n\tv_addc_co_u32_e32 %0, vcc, %0, %0, vcc" : "+v"(bv) : "v"(v), "v"(thA) : "vcc");
                        if (v >= thB && v < thA) { const unsigned s = __hip_atomic_fetch_add(ccnt + r32, 1u, __ATOMIC_RELAXED, __HIP_MEMORY_SCOPE_WORKGROUP); if (s < (unsigned)CAP) { cs[r32 * CAP + s] = v; ck[r32 * CAP + s] = (unsigned short)(32 * (kt + half) + crow(r, hi)); } }
                    }
                    if (half) bits1 = bv; else bits0 = bv;
                }
            } else if (fast && kt + 1 < qt) {
#pragma unroll
                for (int half = 0; half < 2; ++half)
#pragma unroll
                for (int r = 0; r < 16; ++r) {
                    const float v = half ? sc1[r] : sc0[r];
                    const int b0 = bin0f(v, kofs);
                    if (half) bits1 |= (b0 > T0) ? (1u << r) : 0u; else bits0 |= (b0 > T0) ? (1u << r) : 0u;
                    if (b0 == T0) { const unsigned s = __hip_atomic_fetch_add(ccnt + r32, 1u, __ATOMIC_RELAXED, __HIP_MEMORY_SCOPE_WORKGROUP); if (s < (unsigned)CAP) { cs[r32 * CAP + s] = v; ck[r32 * CAP + s] = (unsigned short)(32 * (kt + half) + crow(r, hi)); } }
                }
            } else {
#pragma unroll
                for (int half = 0; half < 2; ++half)
#pragma unroll
                for (int r = 0; r < 16; ++r) {
                    const float v = half ? sc1[r] : sc0[r];
                    const int kp = 32 * (kt + half) + crow(r, hi);
                    if (kp <= t) {
                        const int b0 = bin0f(v, kofs);
                        bool sel = b0 > T0, cand = (b0 == T0);
                        if (cand && L > 0) { const int b1 = binf(v, lo1, in1); sel = b1 > T1; cand = (b1 == T1);
                            if (cand && L > 1) { const int b2 = binf(v, lo2, in2); sel = b2 > T2; cand = (b2 == T2); } }
                        if (sel) { if (half) bits1 |= 1u << r; else bits0 |= 1u << r; }
                        else if (cand) { const unsigned s = __hip_atomic_fetch_add(ccnt + r32, 1u, __ATOMIC_RELAXED, __HIP_MEMORY_SCOPE_WORKGROUP); if (s < (unsigned)CAP) { cs[r32 * CAP + s] = v; ck[r32 * CAP + s] = (unsigned short)kp; } }
                    }
                }
            }
            bits16[kt * 64 + lane] = (unsigned short)bits0;
            bits16[(kt + 1) * 64 + lane] = (unsigned short)bits1;
        }
    }
    __syncthreads();
#ifdef DBG_OVF
    if (tid < 32 && ccnt[tid] > (unsigned)CAP) atomicAdd((unsigned*)((unsigned char*)MASK - WS_MASK) + 3, 1u);
#endif
#ifndef REPR
#define REPR 0
#endif
    for (int repr = 0; repr <= REPR; ++repr)
    for (int qq = 0; qq < 4; ++qq) {
        const int q = 4 * wid + qq; const int nd = needv[q]; unsigned n = ccnt[q]; n = n > (unsigned)CAP ? (unsigned)CAP : n;
        if (nd <= 0 || n == 0u) continue;
        unsigned key[4], kk[4]; bool val[4];
#pragma unroll
        for (int e = 0; e < 4; ++e) { const unsigned i = lane + 64 * e; val[e] = i < n; const unsigned u = val[e] ? __float_as_uint(cs[q * CAP + i]) : 0u; key[e] = (u & 0x80000000u) ? ~u : (u | 0x80000000u); kk[e] = val[e] ? (unsigned)ck[q * CAP + i] : 0xffffffffu; if (!val[e]) key[e] = 0u; }
        unsigned x = 0u;
        for (int bit = 31; bit >= 0; --bit) {
            const unsigned trial = x | (1u << bit); int c = 0;
#pragma unroll
            for (int e = 0; e < 4; ++e) c += __popcll(__ballot(val[e] && key[e] >= trial));
            if (c >= nd) x = trial;
        }
        int cgt = 0;
#pragma unroll
        for (int e = 0; e < 4; ++e) cgt += __popcll(__ballot(val[e] && key[e] > x));
        int ties = nd - cgt;
        bool sel[4];
#pragma unroll
        for (int e = 0; e < 4; ++e) sel[e] = val[e] && key[e] > x;
        unsigned last = 0u; bool first = true;
        for (int it = 0; it < ties; ++it) {
            unsigned best = 0xffffffffu;
#pragma unroll
            for (int e = 0; e < 4; ++e) { const bool ok = val[e] && key[e] == x && (first || kk[e] > last); best = ok && kk[e] < best ? kk[e] : best; }
#pragma unroll
            for (int o = 1; o < 64; o <<= 1) { const unsigned v = __shfl_xor(best, o); best = v < best ? v : best; }
            if (best == 0xffffffffu) break;
#pragma unroll
            for (int e = 0; e < 4; ++e) sel[e] = sel[e] || (val[e] && key[e] == x && kk[e] == best);
            last = best; first = false;
        }
#pragma unroll
        for (int e = 0; e < 4; ++e) if (sel[e]) {
            const unsigned ki = kk[e];
            const int kt = (int)(ki >> 5), cc = (int)(ki & 31u), hh = (cc >> 2) & 1, rr = (cc & 3) + 4 * (cc >> 3);
            const int idx = kt * 64 + hh * 32 + q;
            __hip_atomic_fetch_or(bits32 + (idx >> 1), 1u << (16 * (idx & 1) + rr), __ATOMIC_RELAXED, __HIP_MEMORY_SCOPE_WORKGROUP);
        }
    }
    __syncthreads();
    { const int nw = (qt + 1 + ((qt & 1) == 0 ? 1 : 0)) * 32; unsigned* mw = (unsigned*)MASK + (size_t)qt * 512 * 32;
      for (int i = tid; i < nw; i += 512) mw[i] = bits32[i]; }
    __syncthreads();
}
}

__device__ __forceinline__ void conv_unit(LAS unsigned char* lds, int tile, const bf16_t* U, const float* cw, const float* cb, const float* lg, const float* lb, const bf16_t* SG, bf16_t* YG) {
    const int tid = opaque_tid(), wid = __builtin_amdgcn_readfirstlane(tid >> 6), lane = tid & 63;
    const int t0 = 32 * tile, c0 = 2 * tid;
    float w0[31], w1[31];
#pragma unroll
    for (int j = 0; j < 31; ++j) { const f32x2 v = *(const f32x2*)(cw + j * HALFW + c0); w0[j] = v[0]; w1[j] = v[1]; }
    float y0[32], y1[32];
    { const f32x2 b = *(const f32x2*)(cb + c0);
#pragma unroll
      for (int i = 0; i < 32; ++i) { y0[i] = b[0]; y1[i] = b[1]; } }
#define CONV_LD(dst, base_i) do { _Pragma("unroll") for (int i_ = 0; i_ < 16; ++i_) { const int ti = t0 - 30 + (base_i) + i_; const unsigned v_ = *(const unsigned*)(U + (size_t)(ti < 0 ? 0 : (ti > SEQ - 1 ? SEQ - 1 : ti)) * HALFW + c0); dst[i_] = (ti < 0 || (base_i) + i_ >= 62) ? 0u : v_; } } while (0)
#define CONV_AP(src, base_i) do { _Pragma("unroll") for (int i_ = 0; i_ < 16; ++i_) { const float u0 = bflo(src[i_]), u1 = bfhi(src[i_]); \
        _Pragma("unroll") for (int j = 0; j < 31; ++j) { const int tt = (base_i) + i_ - j; if ((base_i) + i_ < 62 && tt >= 0 && tt < 32) { y0[tt] = fmaf(w0[j], u0, y0[tt]); y1[tt] = fmaf(w1[j], u1, y1[tt]); } } } } while (0)
    { unsigned ua[16], ub[16];
      CONV_LD(ua, 0); CONV_LD(ub, 16); CONV_AP(ua, 0); CONV_LD(ua, 32); CONV_AP(ub, 16); CONV_LD(ub, 48); CONV_AP(ua, 32); CONV_AP(ub, 48); }
#undef CONV_LD
#undef CONV_AP
    float v[64];
#pragma unroll
    for (int i = 0; i < 32; ++i) { v[i] = y0[i] + y1[i]; v[32 + i] = y0[i] * y0[i] + y1[i] * y1[i]; }
#pragma unroll
    for (int k = 32; k >= 1; k >>= 1) {
        const bool up = (lane & k) != 0;
#pragma unroll
        for (int i = 0; i < k; ++i) { const float keep = up ? v[k + i] : v[i], give = up ? v[i] : v[k + i]; v[i] = keep + __shfl_xor(give, k); }
    }
    LAS float* part = (LAS float*)(lds + SCR_OFF);
    LAS float* stat = part + 512;
    __syncthreads();
    part[wid * 64 + lane] = v[0];
    __syncthreads();
    if (tid < 64) { float s = 0.f;
#pragma unroll
        for (int w8 = 0; w8 < 8; ++w8) s += part[w8 * 64 + tid];
        part[tid] = s; }
    __syncthreads();
    if (tid < 32) { const float mean = part[tid] * (1.0f / 1024.0f); const float var = part[32 + tid] * (1.0f / 1024.0f) - mean * mean; stat[tid] = mean; stat[32 + tid] = __builtin_amdgcn_rsqf(fmaxf(var, 0.f) + EPS); }
    __syncthreads();
    const f32x2 g = *(const f32x2*)(lg + c0), bb = *(const f32x2*)(lb + c0);
    unsigned sgv[32];
#pragma unroll
    for (int i = 0; i < 32; ++i) sgv[i] = *(const unsigned*)(SG + (size_t)(t0 + i) * DM + HALFW + c0);
    __builtin_amdgcn_sched_barrier(0);
#pragma unroll
    for (int i = 0; i < 32; ++i) {
        const float mean = stat[i], rstd = stat[32 + i];
        const float a0 = siluf_((y0[i] - mean) * rstd * g[0] + bb[0]), a1 = siluf_((y1[i] - mean) * rstd * g[1] + bb[1]);
        const size_t off = (size_t)(t0 + i) * DM + HALFW + c0;
        const unsigned sg = sgv[i];
        *(unsigned*)(YG + off) = cvt_pk_bf16(a0 * bflo(sg), a1 * bfhi(sg));
    }
}

constexpr int N_PHASES = 26;
struct Args { const float* in[18]; float* out; unsigned char* ws; int ph_lo, ph_hi; };
template <int MASK>
__global__ void __launch_bounds__(512, 2) trunk_fwd(Args a_unused) {
    extern __shared__ __attribute__((aligned(16))) unsigned char lds_raw[];
#define SITE_BEGIN() \
    const __attribute__((address_space(4))) Args* ap = (const __attribute__((address_space(4))) Args*)__builtin_amdgcn_kernarg_segment_ptr(); asm volatile("" : "+s"(ap)); \
    Frame F; { F.tid = opaque_tid(); F.lane = F.tid & 63; F.wave = __builtin_amdgcn_readfirstlane(F.tid >> 6); int b_ = blockIdx.x, g_ = gridDim.x; asm volatile("" : "+s"(b_), "+s"(g_)); F.bid = b_; F.G = g_; } \
    F.lds = (LAS unsigned char*)lds_raw; unsigned char* ws = ap->ws; F.ctl = (unsigned*)(ws + WS_CTL); (void)ws
#define EN(k) (((MASK) >> (k)) & 1)
#define RUN(p) (lo <= (p) && (p) < hi)
#ifdef REPBAR
#define SEAM(p) do { if ((p) + 1 < hi) { xcd_barrier(bar); xcd_barrier(bar); xcd_barrier(bar); } } while (0)
#else
#define SEAM(p) do { if ((p) + 1 < hi) xcd_barrier(bar); } while (0)
#endif
    int lo, hi; XcdBarrier bar;
    {
        const __attribute__((address_space(4))) Args* ap0 = (const __attribute__((address_space(4))) Args*)__builtin_amdgcn_kernarg_segment_ptr();
        lo = ap0->ph_lo; hi = ap0->ph_hi;
        volatile LAS unsigned* MISC = (volatile LAS unsigned*)((LAS unsigned char*)lds_raw + MISC_OFF);
        if (threadIdx.x < 64) MISC[threadIdx.x] = 0u;
        __syncthreads();
        unsigned* barw = (unsigned*)(ap0->ws + WS_CTL) + CW_BAR;
        bar.bar = barw; bar.x = 0; bar.st = nullptr;
        if (hi - lo > 1) bar = xcd_barrier_post(barw, MISC + 8);
    }
    if (EN(0) && RUN(0)) { SITE_BEGIN();
#ifdef REP0
        for (int rep_ = 0; rep_ < 2; ++rep_)
#endif
        phase_p0a(F, ap->in[1], ap->in[3], ap->in[5], ap->in[6], ap->in[7], ap->in[11], ws); SEAM(0); }
    if (EN(1) && RUN(1)) { SITE_BEGIN(); phase_p0b(F, ap->in[4], ws); SEAM(1); }
    for (int lp = 0; lp < 2; ++lp) {
        const int pb = 2 + 12 * lp;
        if (EN(2) && RUN(pb + 0)) { SITE_BEGIN(); const int l = 2 * lp;
            if (l == 0) phase_norm<false>(F, ap->in[0], ap->in[2] + l * DM, (const float*)(ws + WS_MODF) + l * 6144, (bf16_t*)(ws + WS_H));
            else phase_norm<true>(F, ws + WS_XB, ap->in[2] + l * DM, (const float*)(ws + WS_MODF) + l * 6144, (bf16_t*)(ws + WS_H));
            SEAM(pb + 0); }
        if (EN(3) && RUN(pb + 1)) { SITE_BEGIN(); const int e = lp;
#ifdef REP3
            for (int rep_ = 0; rep_ < 2; ++rep_) {
#endif
            const bf16_t* WEV = (const bf16_t*)(ws + WS_WEV) + (size_t)e * EV_N * DM; const bf16_t* H = (const bf16_t*)(ws + WS_H);
            { pg8::Gemm g{H, WEV, SEQ, EV_MAIN, DM}; pg8::StaticOrder S; S.init(SEQ, EV_MAIN, F.G, F.bid);
              epi::EpiEven E{ws, (float*)(ws + WS_CTL + CTL_KMEAN_OFF) + (size_t)e * 65536, ap->in[9] + e * HD, ap->in[10] + e * HD, F.lds + SCR_OFF};
              pg8::gemm_phase(F.lds, g, S, E); }
#ifndef NO_VT
            { pg8::Gemm g{WEV + (size_t)EV_MAIN * DM, H, HALFW, SEQ, DM}; pg8::StaticOrder S; S.init(HALFW, SEQ, F.G, F.bid);
              epi::EpiVT E{(bf16_t*)(ws + WS_VT)}; pg8::gemm_phase(F.lds, g, S, E); }
#endif
#ifdef REP3
            }
#endif
            SEAM(pb + 1); }
        if (EN(4) && RUN(pb + 2)) { SITE_BEGIN(); const int e = lp;
#ifdef REPD
            for (int rep_ = 0; rep_ < 2; ++rep_)
#endif
            phase_pool_d(F, (const bf16_t*)(ws + WS_UA), (bf16_t*)(ws + WS_D));
            float knb; { const float* kn = ap->in[10] + e * HD; float mx = fmaxf(fabsf(kn[F.lane]), fabsf(kn[64 + F.lane]));
#pragma unroll
              for (int o_ = 1; o_ < 64; o_ <<= 1) mx = fmaxf(mx, __shfl_xor(mx, o_));
              knb = mx * 11.3137085f * 1.01f; }
            phase_top3(F, (const bf16_t*)(ws + WS_Q), (const float*)(ws + WS_CTL + CTL_KMEAN_OFF) + (size_t)e * 65536, F.ctl + CW_CNT + e * 512 * 16, (unsigned*)(ws + WS_LIST), (float*)(ws + WS_PARTML), knb); SEAM(pb + 2); }
        if (EN(5) && RUN(pb + 3)) { SITE_BEGIN(); const int e = lp;
#ifdef REP5
            for (int rep_ = 0; rep_ < 2; ++rep_) {
#endif
            { pg8::Gemm g{(const bf16_t*)(ws + WS_D), (const bf16_t*)(ws + WS_PWT) + (size_t)e * 4 * 65536, 4 * SEQ, HALFW, 256}; pg8::PoolOrder S{F.G, F.bid};
              epi::EpiPool E{ap->in[8] + e * HALFW, (const bf16_t*)(ws + WS_SG), (bf16_t*)(ws + WS_H)}; pg8::gemm_phase(F.lds, g, S, E); }
            LAS int* offt = (LAS int*)(F.lds + 158720);
            const unsigned* cnt = F.ctl + CW_CNT + e * 512 * 16;
            __syncthreads();
            if (F.wave == 0) {
                int loc[8]; int s = 0;
#pragma unroll
                for (int i = 0; i < 8; ++i) { const int idx = F.lane * 8 + i; const int c = (int)__hip_atomic_load(cnt + idx * 16, __ATOMIC_RELAXED, __HIP_MEMORY_SCOPE_AGENT); loc[i] = ((idx & 63) < 63) ? ((c + 255) >> 8) : 0; s += loc[i]; }
                int inc = s;
#pragma unroll
                for (int off = 1; off < 64; off <<= 1) { const int v = __shfl_up(inc, off); if (F.lane >= off) inc += v; }
                int ex = inc - s;
#pragma unroll
                for (int i = 0; i < 8; ++i) { offt[F.lane * 8 + i] = ex; ex += loc[i]; }
                if (F.lane == 63) offt[512] = inc;
            }
            __syncthreads();
            const int total = offt[512];
            for (int u = F.bid; u < total; u += F.G) {
                int lo_ = 0, hi_ = 511;
                while (lo_ < hi_) { const int mid = (lo_ + hi_ + 1) >> 1; if (offt[mid] <= u) lo_ = mid; else hi_ = mid - 1; }
                const int idx = lo_, c = u - offt[idx];
                att::moba_sel_unit(F.lds, idx >> 6, idx & 63, c, (int)__hip_atomic_load(cnt + idx * 16, __ATOMIC_RELAXED, __HIP_MEMORY_SCOPE_AGENT), (const unsigned*)(ws + WS_LIST), (const bf16_t*)(ws + WS_Q), (const bf16_t*)(ws + WS_K), (const bf16_t*)(ws + WS_VT),
                                   (bf16_t*)(ws + WS_PARTO), (float*)(ws + WS_PARTML));
            }
#ifdef REP5
            }
#endif
            SEAM(pb + 3); }
        if (EN(6) && RUN(pb + 4)) { SITE_BEGIN();
#ifdef REP6
            for (int rep_ = 0; rep_ < 2; ++rep_)
#endif
            for (int u = F.bid; u < 512; u += F.G) att::moba_own_unit(F.lds, u & 7, u >> 3, (const bf16_t*)(ws + WS_Q), (const bf16_t*)(ws + WS_K), (const bf16_t*)(ws + WS_VT),
                                                                     (const bf16_t*)(ws + WS_PARTO), (const float*)(ws + WS_PARTML), (const bf16_t*)(ws + WS_SG), (bf16_t*)(ws + WS_H));
            SEAM(pb + 4); }
        if (EN(7) && RUN(pb + 5)) { SITE_BEGIN(); const int l = 2 * lp;
            pg8::Gemm g{(const bf16_t*)(ws + WS_H), (const bf16_t*)(ws + WS_WOUT) + (size_t)l * DM * DM, SEQ, DM, DM}; pg8::StaticOrder S; S.init(SEQ, DM, F.G, F.bid);
            if (l == 0) { epi::EpiOut<false, true> E{ap->in[0], ws + WS_XB, (const float*)(ws + WS_MODF) + l * 6144 + 2 * DM, F.lds + SCR_OFF}; pg8::gemm_phase(F.lds, g, S, E); }
            else { epi::EpiOut<true, true> E{ws + WS_XB, ws + WS_XB, (const float*)(ws + WS_MODF) + l * 6144 + 2 * DM, F.lds + SCR_OFF}; pg8::gemm_phase(F.lds, g, S, E); }
            SEAM(pb + 5); }
        if (EN(8) && RUN(pb + 6)) { SITE_BEGIN(); const int l = 2 * lp + 1;
#ifdef REPN
            for (int rep_ = 0; rep_ < 2; ++rep_)
#endif
            phase_norm<true>(F, ws + WS_XB, ap->in[2] + l * DM, (const float*)(ws + WS_MODF) + l * 6144, (bf16_t*)(ws + WS_H)); SEAM(pb + 6); }
        if (EN(9) && RUN(pb + 7)) { SITE_BEGIN(); const int o = lp;
#ifdef REP9
            for (int rep_ = 0; rep_ < 2; ++rep_) {
#endif
            const bf16_t* WOD = (const bf16_t*)(ws + WS_WOD) + (size_t)o * OD_N * DM; const bf16_t* H = (const bf16_t*)(ws + WS_H);
            { pg8::Gemm g{H, WOD, SEQ, OD_MAIN, DM}; pg8::StaticOrder S; S.init(SEQ, OD_MAIN, F.G, F.bid);
              epi::EpiOdd E{ws, F.ctl + CW_KIMAX + o * 8, ap->in[12] + o * HD, ap->in[13] + o * HD, F.lds + SCR_OFF};
              pg8::gemm_phase(F.lds, g, S, E); }
            { pg8::Gemm g{WOD + (size_t)OD_MAIN * DM, H, HALFW, SEQ, DM}; pg8::StaticOrder S; S.init(HALFW, SEQ, F.G, F.bid);
              epi::EpiVT E{(bf16_t*)(ws + WS_VT)}; pg8::gemm_phase(F.lds, g, S, E); }
#ifdef REP9
            }
#endif
            SEAM(pb + 7); }
        if (EN(10) && RUN(pb + 8)) {
            { SITE_BEGIN(); const int o = lp;
#ifdef REPC
              for (int rep_ = 0; rep_ < 2; ++rep_)
#endif
              for (int tile = F.bid; tile < 512; tile += F.G)
                  conv_unit(F.lds, tile, (const bf16_t*)(ws + WS_U), ap->in[14] + (size_t)o * 31 * HALFW, ap->in[15] + o * HALFW, ap->in[16] + o * HALFW, ap->in[17] + o * HALFW, (const bf16_t*)(ws + WS_SG), (bf16_t*)(ws + WS_H)); }
            { SITE_BEGIN(); const int o = lp;
              const unsigned* kimax = F.ctl + CW_KIMAX + o * 8;
              float kb2 = 0.f;
#pragma unroll
              for (int i = 0; i < 8; ++i) kb2 += __uint_as_float(__hip_atomic_load(kimax + i, __ATOMIC_RELAXED, __HIP_MEMORY_SCOPE_AGENT));
              const float kib = sqrtf(kb2);
              __syncthreads();
#ifdef REP10
              for (int rep_ = 0; rep_ < 2; ++rep_)
#endif
              for (int p = F.bid; p < 512; p += F.G) { const int qt = p < 256 ? p : 767 - p;
                  dsa::select_unit(F.lds, qt, (const bf16_t*)(ws + WS_QI), (const float*)(ws + WS_WI), (const bf16_t*)(ws + WS_KI), kib, (unsigned short*)(ws + WS_MASK)); } }
            SEAM(pb + 8); }
        if (EN(11) && RUN(pb + 9)) { SITE_BEGIN();
            float knb; { const float* kn = ap->in[13] + lp * HD; float mx = fmaxf(fabsf(kn[F.lane]), fabsf(kn[64 + F.lane]));
#pragma unroll
              for (int o_ = 1; o_ < 64; o_ <<= 1) mx = fmaxf(mx, __shfl_xor(mx, o_));
              knb = mx * 11.3137085f * 1.01f; }
            LAS int* uq = (LAS int*)(F.lds + att::ATT_SCR + 256);
            for (;;) {
                __syncthreads();
                if (F.tid == 0) uq[0] = (int)atomicAdd(F.ctl + CW_DQ + lp, 1u);
                __syncthreads();
                const int u = uq[0]; if (u >= 608) break;
                int h, qb, j0, j1, slot = -1;
                if (u < 64) { h = 6; qb = 63 - u; j0 = 0; j1 = 4 * qb + 4; }
                else if (u < 208) { int v = u - 64, k, c;
                    if (v < 64) { k = v >> 2; c = v & 3; } else if (v < 112) { v -= 64; k = 16 + v / 3; c = v % 3; } else { v -= 112; k = 32 + (v >> 1); c = v & 1; }
                    h = 7; qb = 63 - k; const int T = 4 * qb + 4; j1 = T - 64 * c; j0 = j1 - 64 < 0 ? 0 : j1 - 64; slot = 4 * k + c; }
                else if (u < 224) { h = 7; qb = 15 - (u - 208); j0 = 0; j1 = 4 * qb + 4; }
                else { const int k = u - 224; h = 5 - (k >> 6); qb = 63 - (k & 63); j0 = 0; j1 = 4 * qb + 4; }
                att::dsa_unit(F.lds, h, qb, j0, j1, slot, (const bf16_t*)(ws + WS_Q), (const bf16_t*)(ws + WS_K), (const bf16_t*)(ws + WS_VT), (const unsigned short*)(ws + WS_MASK), (const bf16_t*)(ws + WS_SG), (bf16_t*)(ws + WS_H),
                              (bf16_t*)(ws + WS_PARTO), (float*)(ws + WS_PARTML), knb);
            }
            SEAM(pb + 9); }
        if (EN(13) && RUN(pb + 10)) { SITE_BEGIN();
            att::dsa_merge(F.bid, F.G, F.tid, (const bf16_t*)(ws + WS_PARTO), (const float*)(ws + WS_PARTML), (const bf16_t*)(ws + WS_SG), (bf16_t*)(ws + WS_H));
            SEAM(pb + 10); }
        if (EN(12) && RUN(pb + 11)) { SITE_BEGIN(); const int l = 2 * lp + 1;
            pg8::Gemm g{(const bf16_t*)(ws + WS_H), (const bf16_t*)(ws + WS_WOUT) + (size_t)l * DM * DM, SEQ, DM, DM}; pg8::StaticOrder S; S.init(SEQ, DM, F.G, F.bid);
            if (l == 3) { epi::EpiOut<true, false> E{ws + WS_XB, ap->out, (const float*)(ws + WS_MODF) + l * 6144 + 2 * DM, F.lds + SCR_OFF}; pg8::gemm_phase(F.lds, g, S, E); }
            else { epi::EpiOut<true, true> E{ws + WS_XB, ws + WS_XB, (const float*)(ws + WS_MODF) + l * 6144 + 2 * DM, F.lds + SCR_OFF}; pg8::gemm_phase(F.lds, g, S, E); }
            SEAM(pb + 11); }
    }
#undef RUN
#undef SEAM
#undef EN
#undef SITE_BEGIN
}

#ifndef N_LAUNCH_MODE
#define N_LAUNCH_MODE 1
#endif
template <int MASK> static void launch_one(int grid, const Args& a, hipStream_t stream) {
    static bool attr = false;
    if (!attr) { attr = true; if (hipFuncSetAttribute((const void*)trunk_fwd<MASK>, hipFuncAttributeMaxDynamicSharedMemorySize, LDS_BYTES) != hipSuccess) fprintf(stderr, "kernel_launch: hipFuncSetAttribute failed\n"); }
    hipLaunchKernelGGL(trunk_fwd<MASK>, dim3(grid), dim3(512), LDS_BYTES, stream, a);
}
extern "C" void kernel_launch(void* const* d_in, const int* in_sizes, int n_in, void* d_out, int out_size, void* d_ws, size_t ws_size, hipStream_t stream) {
    static int grid = 0;
    if (grid == 0) {
        if (n_in != 18 || in_sizes[0] != SEQ * DM || out_size != SEQ * DM || ws_size < WS_END) { fprintf(stderr, "kernel_launch: unexpected shapes (n_in %d, ws %zu)\n", n_in, ws_size); grid = -1; return; }
        int dev = 0, cus = 0;
        if (hipGetDevice(&dev) != hipSuccess || hipDeviceGetAttribute(&cus, hipDeviceAttributeMultiprocessorCount, dev) != hipSuccess) { grid = -1; return; }
        grid = cus;
    }
    if (grid < 0) return;
    if (hipMemsetAsync((char*)d_ws + WS_CTL, 0, CTL_ZERO_BYTES, stream) != hipSuccess) return;
    Args a{};
    for (int i = 0; i < 18; ++i) a.in[i] = (const float*)d_in[i];
    a.out = (float*)d_out; a.ws = (unsigned char*)d_ws;
#if N_LAUNCH_MODE == 1
    a.ph_lo = 0; a.ph_hi = N_PHASES;
    launch_one<0x3fff>(grid, a, stream);
#else
    for (int p = 0; p < N_PHASES; ++p) {
        a.ph_lo = p; a.ph_hi = p + 1;
        const int r_ = p < 2 ? 0 : (p - 2) % 12; const int site = p < 2 ? p : (r_ < 10 ? 2 + r_ : (r_ == 10 ? 13 : 12));
        switch (site) {
            case 0: launch_one<1 << 0>(grid, a, stream); break; case 1: launch_one<1 << 1>(grid, a, stream); break; case 2: launch_one<1 << 2>(grid, a, stream); break;
            case 3: launch_one<1 << 3>(grid, a, stream); break; case 4: launch_one<1 << 4>(grid, a, stream); break; case 5: launch_one<1 << 5>(grid, a, stream); break;
            case 6: launch_one<1 << 6>(grid, a, stream); break; case 7: launch_one<1 << 7>(grid, a, stream); break; case 8: launch_one<1 << 8>(grid, a, stream); break;
            case 9: launch_one<1 << 9>(grid, a, stream); break; case 10: launch_one<1 << 10>(grid, a, stream); break; case 11: launch_one<1 << 11>(grid, a, stream); break;
            case 12: launch_one<1 << 12>(grid, a, stream); break;
            default: launch_one<1 << 13>(grid, a, stream); break;
        }
    }
#endif
}
```

```cpp
#include <hip/hip_runtime.h>
#include <cstdio>
#include <cstdint>

#define LAS __attribute__((address_space(3)))
#define GAS __attribute__((address_space(1)))
typedef unsigned short bf16_t;
typedef short bf16x8 __attribute__((ext_vector_type(8)));
typedef short s16x4 __attribute__((ext_vector_type(4)));
typedef float f32x2 __attribute__((ext_vector_type(2)));
typedef float f32x4 __attribute__((ext_vector_type(4)));
typedef float f32x16 __attribute__((ext_vector_type(16)));
typedef unsigned u32x2 __attribute__((ext_vector_type(2)));
typedef unsigned u32x4 __attribute__((ext_vector_type(4)));

constexpr int SEQ = 16384, DM = 2048, HALFW = 1024, HD = 128, NH = 8;
constexpr int EV_N = 6144, OD_SRC_N = 7752, OD_N = 7936;
constexpr int EV_MAIN = 5120, OD_MAIN = 6912;
constexpr float EPS = 1e-6f;
constexpr float SCALE = 0.08838834764831845f;
constexpr float LOG2E = 1.4426950408889634f;
constexpr float C2 = SCALE * LOG2E;
constexpr float NEG_INF = -__builtin_inff();

constexpr size_t MiB = 1u << 20;
constexpr size_t WS_CTL = 0, CTL_ZERO_BYTES = 1 * MiB, CTL_KMEAN_OFF = 262144;
constexpr size_t WS_MODP = 1 * MiB, WS_MODF = 2 * MiB, WS_KMEAN = 3 * MiB, WS_PWT = 4 * MiB;
constexpr size_t WS_WOUT = 8 * MiB, WS_WEV = 40 * MiB, WS_WOD = 88 * MiB;
constexpr size_t WS_H = 150 * MiB, WS_SG = 214 * MiB, WS_Q = 278 * MiB, WS_K = 310 * MiB, WS_VT = 342 * MiB;
constexpr size_t WS_UA = 374 * MiB, WS_D = 406 * MiB, WS_LIST = 438 * MiB, WS_PARTO = 470 * MiB, WS_PARTML = 566 * MiB;
constexpr size_t WS_QI = 374 * MiB, WS_KI = 390 * MiB, WS_WI = 392 * MiB, WS_U = 394 * MiB, WS_MASK = 426 * MiB;
constexpr size_t WS_XB = 570 * MiB;
constexpr size_t WS_END = 634 * MiB;
constexpr int CW_BAR = 4096;
constexpr int CW_CNT = 16384;
constexpr int CW_KIMAX = 16384 + 2 * 512 * 16;
constexpr int CW_DQ = CW_KIMAX + 64;
static_assert((CW_DQ + 64) * 4 <= (int)CTL_ZERO_BYTES, "ctl");

constexpr int RING_BYTES = 131072;
constexpr int SCR_OFF = RING_BYTES;
constexpr int LDS_BYTES = 163840;
constexpr int MISC_OFF = LDS_BYTES - 256;

__device__ __forceinline__ unsigned cvt_pk_bf16(float lo, float hi) { unsigned r; asm volatile("v_cvt_pk_bf16_f32 %0, %1, %2" : "=v"(r) : "v"(lo), "v"(hi)); return r; }
__device__ __forceinline__ float bf2f(unsigned short b) { return __uint_as_float((unsigned)b << 16); }
__device__ __forceinline__ float bflo(unsigned w) { return __uint_as_float(w << 16); }
__device__ __forceinline__ float bfhi(unsigned w) { return __uint_as_float(w & 0xffff0000u); }
__device__ __forceinline__ int crow(int r, int hi) { return (r & 3) + 8 * (r >> 2) + 4 * hi; }
__device__ __forceinline__ float fast_exp2(float x) { return __builtin_amdgcn_exp2f(x); }
__device__ __forceinline__ float sigmoidf_(float x) { return __builtin_amdgcn_rcpf(1.0f + __expf(-x)); }
__device__ __forceinline__ float siluf_(float x) { return x * __builtin_amdgcn_rcpf(1.0f + __expf(-x)); }
#define LDS_WAIT() asm volatile("s_waitcnt lgkmcnt(0)" ::: "memory")
#define VM_WAIT() asm volatile("s_waitcnt vmcnt(0)" ::: "memory")
#define WG_BAR() do { asm volatile("s_waitcnt lgkmcnt(0)" ::: "memory"); __builtin_amdgcn_s_barrier(); asm volatile("" ::: "memory"); } while (0)

__device__ __forceinline__ int opaque_tid() { int t = threadIdx.x; asm volatile("" : "+v"(t)); return t; }

#define XB_TMO      128
#define XB_XCNT(j)  (256  + 64 * (j))
#define XB_XSUB(j)  (1280 + 64 * (j))
#define XB_XGEN(j)  (2304 + 64 * (j))
#define XB_TOP      3328
#define XB_TOPGEN   3392
#define XCD_BAR_WORDS 3456
#define XB_SPIN_CAP (1u << 18)

__device__ __forceinline__ unsigned xb_ld(unsigned* p)              { return __hip_atomic_load(p, __ATOMIC_RELAXED, __HIP_MEMORY_SCOPE_AGENT); }
__device__ __forceinline__ unsigned xb_add(unsigned* p, unsigned v) { return __hip_atomic_fetch_add(p, v, __ATOMIC_RELAXED, __HIP_MEMORY_SCOPE_AGENT); }
__device__ __forceinline__ unsigned xb_xcc_id() { return (unsigned)__builtin_amdgcn_s_getreg((3 << 11) | 20) & 0xFu; }
#define XB_SPIN(cond, bar) do { unsigned _sp = 0; while (cond) { __builtin_amdgcn_s_sleep(1); \
    if ((++_sp & 255u) == 0u) { if (xb_ld(&(bar)[XB_TMO])) break; if (_sp > XB_SPIN_CAP) { atomicAdd(&(bar)[XB_TMO], 1u); break; } } } } while (0)

struct XcdBarrier {
    unsigned* bar; unsigned x;
    volatile LAS unsigned* st;
};

__device__ __forceinline__ XcdBarrier xcd_barrier_post(unsigned* bar, volatile LAS unsigned* st) {
    XcdBarrier b; b.bar = bar; b.x = xb_xcc_id(); b.st = st;
    if (threadIdx.x == 0) (void)xb_add(&bar[XB_XCNT(b.x)], 1u);
    return b;
}
__device__ __forceinline__ void xcd_barrier_complete(unsigned* bar, unsigned x, unsigned& nloc, unsigned& nx) {
    const unsigned G = gridDim.x * gridDim.y * gridDim.z;
    unsigned sum, cnt, mine, sp = 0u;
    for (;;) {
        sum = 0u; cnt = 0u; mine = 0u;
#pragma unroll
        for (unsigned j = 0; j < 16; ++j) { const unsigned c = xb_ld(&bar[XB_XCNT(j)]); sum += c; cnt += (c > 0u) ? 1u : 0u; mine = (j == x) ? c : mine; }
        if (sum == G) break;
        __builtin_amdgcn_s_sleep(1);
        if ((++sp & 255u) == 0u) { if (xb_ld(&bar[XB_TMO])) break; if (sp > XB_SPIN_CAP) { atomicAdd(&bar[XB_TMO], 1u); break; } }
    }
    nloc = mine > 0u ? mine : 1u; nx = cnt > 0u ? cnt : 1u;
}

__device__ __forceinline__ void xcd_barrier(const XcdBarrier& b) {
    asm volatile("s_waitcnt vmcnt(0)" ::: "memory");
    __syncthreads();
    if (threadIdx.x == 0) {
        unsigned* bar = b.bar;
        __builtin_amdgcn_s_waitcnt(0);
        unsigned nloc = b.st[0], nx = b.st[1];
        if (nloc == 0u) { xcd_barrier_complete(bar, b.x, nloc, nx); b.st[0] = nloc; b.st[1] = nx; }
        const unsigned old = xb_add(&bar[XB_XSUB(b.x)], 1u);
        const unsigned gen = old / nloc;
        if (old + 1u == (gen + 1u) * nloc) {
            __builtin_amdgcn_fence(__ATOMIC_RELEASE, "agent");
            asm volatile("s_waitcnt vmcnt(0)" ::: "memory");
            const unsigned og = xb_add(&bar[XB_TOP], 1u);
            const unsigned tg = og / nx;
            if (og + 1u == (tg + 1u) * nx) xb_add(&bar[XB_TOPGEN], 1u);
            else XB_SPIN(xb_ld(&bar[XB_TOPGEN]) == tg, bar);
            __builtin_amdgcn_fence(__ATOMIC_ACQUIRE, "agent");
            xb_add(&bar[XB_XGEN(b.x)], 1u);
            asm volatile("s_waitcnt vmcnt(0)" ::: "memory");
        } else {
            XB_SPIN(xb_ld(&bar[XB_XGEN(b.x)]) == gen, bar);
            __builtin_amdgcn_fence(__ATOMIC_ACQUIRE, "agent");
            asm volatile("s_waitcnt vmcnt(0)" ::: "memory");
        }
    }
    __syncthreads();
}

namespace pg8 {
constexpr int BM = 256, BK = 64, HALF = 128, HTB = HALF * BK * 2, STAGE_BYTES = 8 * HTB, NXCD = 8, WGM = 8;
__host__ __device__ __forceinline__ int lds_byte(int r, int c) { const int st = (r >> 4) * 2 + (c >> 5), rr = r & 15, cc = c & 31, ob = rr * 64 + cc * 2; return st * 1024 + (ob ^ (((ob >> 9) & 1) << 5)); }
__host__ __device__ __forceinline__ void stage_rc(int b, int& R, int& C) { const int st = b / 1024, sb = b % 1024, swz = sb ^ (((sb >> 9) & 1) << 5); R = (st >> 1) * 16 + swz / 64; C = (st & 1) * 32 + (swz % 64) / 2; }
__host__ __device__ __forceinline__ int perm32(int rho) { const int n = rho >> 4, i = rho & 15; return 8 * (i >> 2) + 4 * n + (i & 3); }
struct Unit { int pm, pn; };
struct Gemm { const bf16_t* A; const bf16_t* Bt; int M, N, K; };
struct StaticOrder {
    int nM, nN, nwg, G, c;
    __device__ void init(int M, int N, int G_, int c_) { nM = M / BM; nN = N / BM; nwg = nM * nN; G = G_; c = c_; }
    __device__ bool next(int i, Unit& u) const {
        const long L = (long)i * G + c; if (L >= nwg) return false;
        int wgid = (int)L; { const int q = nwg / NXCD, r = nwg % NXCD, xcd = wgid % NXCD, off = wgid / NXCD; wgid = (xcd < r ? xcd * (q + 1) : r * (q + 1) + (xcd - r) * q) + off; }
        const int nig = WGM * nN, gid = wgid / nig, fm = gid * WGM, gsz = (nM - fm) < WGM ? (nM - fm) : WGM;
        u.pm = fm + ((wgid % nig) % gsz); u.pn = (wgid % nig) / gsz; return true;
    }
};
#ifdef REP7B
struct RepOrder {
    int nM, nN, nwg, G, c, reps;
    __device__ void init(int M, int N, int G_, int c_, int reps_) { nM = M / BM; nN = N / BM; nwg = nM * nN; G = G_; c = c_; reps = reps_; }
    __device__ bool next(int i, Unit& u) const {
        const long L = (long)i * G + c; if (L >= (long)nwg * reps) return false;
        int wgid = (int)(L % nwg); { const int q = nwg / NXCD, r = nwg % NXCD, xcd = wgid % NXCD, off = wgid / NXCD; wgid = (xcd < r ? xcd * (q + 1) : r * (q + 1) + (xcd - r) * q) + off; }
        const int nig = WGM * nN, gid = wgid / nig, fm = gid * WGM, gsz = (nM - fm) < WGM ? (nM - fm) : WGM;
        u.pm = fm + ((wgid % nig) % gsz); u.pn = (wgid % nig) / gsz; return true;
    }
};
#endif
struct PoolOrder {
    int G, c;
    __device__ bool next(int i, Unit& u) const { const int L = i * G + c; if (L >= 256) return false; u.pm = L; u.pn = L >> 6; return true; }
};

template <class Epi, class Sched>
__device__ __forceinline__ void gemm_phase(LAS unsigned char* lds, const Gemm g, const Sched& S, const Epi& E) {
    const int tid = opaque_tid(), wid = __builtin_amdgcn_readfirstlane(tid >> 6), lane = tid & 63, wr = wid >> 2, wc = wid & 3, fr = lane & 15, fq = lane >> 4;
    int K = g.K; asm volatile("" : "+s"(K));
    const int nt = K / BK;
    unsigned voffA, voffB;
    { int R, C; stage_rc(tid * 16, R, C); const int Rb = Epi::PERM ? ((R & ~31) + perm32(R & 31)) : R;
      voffA = (unsigned)(R * K + C) * 2u; voffB = (unsigned)(Rb * K + C) * 2u; }
    const size_t pstep = (size_t)64 * K * 2;
    const size_t kstep = (size_t)(BK * 2);
    const size_t hstep = (size_t)HALF * K * 2;
    const size_t tstep = 2 * hstep;
    const unsigned ldsw = (unsigned)wid * 1024u;
    const int aoff = lds_byte(wr * 64 + fr, fq * 8), boff = lds_byte(wc * 32 + fr, fq * 8);
#define PG8_SA(b, h) (((b) * 2 + (h)) * HTB)
#define PG8_SB(b, h) ((4 + (b) * 2 + (h)) * HTB)
#define PG8_STAGE(bufoff, gbase, voff) do { _Pragma("unroll") for (int _i = 0; _i < 2; ++_i) \
        __builtin_amdgcn_global_load_lds((const unsigned*)((const char*)(gbase) + _i * pstep + (voff)), (LAS unsigned*)(lds + (bufoff) + ldsw + _i * 8192), 16, 0, 0); } while (0)
#define PG8_LDA(dst, b, h) do { _Pragma("unroll") for (int m = 0; m < 4; ++m) _Pragma("unroll") for (int k = 0; k < 2; ++k) dst[m][k] = *(const LAS bf16x8*)(lds + PG8_SA(b, h) + aoff + m * 2048 + k * 1024); } while (0)
#define PG8_LDB(dst, b, h) do { _Pragma("unroll") for (int n = 0; n < 2; ++n) _Pragma("unroll") for (int k = 0; k < 2; ++k) dst[n][k] = *(const LAS bf16x8*)(lds + PG8_SB(b, h) + boff + n * 2048 + k * 1024); } while (0)
#define PG8_MMA(ai, bj, At, Bt) do { __builtin_amdgcn_s_setprio(1); _Pragma("unroll") for (int m = 0; m < 4; ++m) _Pragma("unroll") for (int n = 0; n < 2; ++n) _Pragma("unroll") for (int k = 0; k < 2; ++k) \
        acc[ai][bj][m][n] = __builtin_amdgcn_mfma_f32_16x16x32_bf16(Bt[n][k], At[m][k], acc[ai][bj][m][n], 0, 0, 0); __builtin_amdgcn_s_setprio(0); } while (0)
#define PG8_WAIT_V(n) asm volatile("s_waitcnt vmcnt(" #n ")" ::: "memory")
#define PG8_WAIT_L(n) asm volatile("s_waitcnt lgkmcnt(" #n ")" ::: "memory")
#define PG8_BAR __builtin_amdgcn_s_barrier()
#define PG8_SCHED __builtin_amdgcn_sched_barrier(0)
    Unit cur, nxt; int ui = 0;
    if (!S.next(0, cur)) return;
    f32x4 acc[2][2][4][2];
#pragma unroll
    for (int a = 0; a < 2; ++a)
#pragma unroll
        for (int b = 0; b < 2; ++b)
#pragma unroll
            for (int m = 0; m < 4; ++m)
#pragma unroll
                for (int n = 0; n < 2; ++n) acc[a][b][m][n] = (f32x4){0.f, 0.f, 0.f, 0.f};
    bf16x8 At[4][2], B0[2][2], B1[2][2];
    const char* cA = (const char*)g.A + (size_t)cur.pm * tstep; const char* cB = (const char*)g.Bt + (size_t)cur.pn * tstep;
#define PG8_FENCE asm volatile("" : "+v"(voffA), "+v"(voffB))
    PG8_FENCE; PG8_STAGE(PG8_SB(0, 0), cB, voffB); PG8_FENCE; PG8_STAGE(PG8_SB(0, 1), cB + hstep, voffB); PG8_FENCE; PG8_STAGE(PG8_SA(0, 0), cA, voffA); PG8_FENCE; PG8_STAGE(PG8_SA(0, 1), cA + hstep, voffA); PG8_FENCE;
    if (wr == 1) PG8_BAR;
    PG8_WAIT_V(2); PG8_BAR;
    PG8_STAGE(PG8_SB(1, 0), cB + kstep, voffB); PG8_FENCE; PG8_STAGE(PG8_SA(1, 0), cA + kstep, voffA); PG8_FENCE; PG8_STAGE(PG8_SB(1, 1), cB + hstep + kstep, voffB); PG8_FENCE;
    PG8_WAIT_V(6); PG8_BAR;
    for (;;) {
        const bool has_next = S.next(ui + 1, nxt);
        const char* nA = has_next ? (const char*)g.A + (size_t)nxt.pm * tstep : cA; const char* nB = has_next ? (const char*)g.Bt + (size_t)nxt.pn * tstep : cB;
#ifdef REPE
        const int ntt = nt * Epi::REPS;
        for (int t = 0; t < ntt; t += 2) {
            const bool last = (t == ntt - 2);
            const char* a1 = cA + (size_t)((t + 1) & (nt - 1)) * kstep;
            const char* a2 = last ? nA : cA + (size_t)((t + 2) & (nt - 1)) * kstep; const char* b2 = last ? nB : cB + (size_t)((t + 2) & (nt - 1)) * kstep;
#else
        for (int t = 0; t < nt; t += 2) {
            const bool last = (t == nt - 2);
            const char* a1 = cA + (size_t)(t + 1) * kstep;
            const char* a2 = last ? nA : cA + (size_t)(t + 2) * kstep; const char* b2 = last ? nB : cB + (size_t)(t + 2) * kstep;
#endif
            const char* a3 = a2 + kstep; const char* b3 = b2 + kstep;
            PG8_LDB(B0, 0, 0); PG8_LDB(B1, 0, 1); PG8_SCHED; PG8_LDA(At, 0, 0); PG8_STAGE(PG8_SA(1, 1), a1 + hstep, voffA);
            PG8_WAIT_V(8); PG8_WAIT_L(0); PG8_BAR; PG8_MMA(0, 0, At, B0); PG8_MMA(0, 1, At, B1); PG8_BAR; PG8_SCHED;
            PG8_LDA(At, 0, 1); PG8_STAGE(PG8_SB(0, 0), b2, voffB); PG8_STAGE(PG8_SB(0, 1), b2 + hstep, voffB); PG8_STAGE(PG8_SA(0, 0), a2, voffA);
            PG8_WAIT_V(8); PG8_WAIT_L(0); PG8_BAR; PG8_MMA(1, 0, At, B0); PG8_MMA(1, 1, At, B1); PG8_BAR; PG8_SCHED;
            PG8_LDB(B0, 1, 0); PG8_LDB(B1, 1, 1); PG8_SCHED; PG8_LDA(At, 1, 0); PG8_STAGE(PG8_SA(0, 1), a2 + hstep, voffA);
            PG8_WAIT_V(8); PG8_WAIT_L(0); PG8_BAR; PG8_MMA(0, 0, At, B0); PG8_MMA(0, 1, At, B1); PG8_BAR; PG8_SCHED;
            PG8_LDA(At, 1, 1); PG8_STAGE(PG8_SB(1, 0), b3, voffB); PG8_STAGE(PG8_SB(1, 1), b3 + hstep, voffB); PG8_STAGE(PG8_SA(1, 0), a3, voffA);
            PG8_WAIT_V(8); PG8_WAIT_L(0); PG8_BAR; PG8_MMA(1, 0, At, B0); PG8_MMA(1, 1, At, B1); PG8_BAR; PG8_SCHED;
        }
#ifdef REPE
        if (Epi::REPS == 2) {
#pragma unroll
            for (int a = 0; a < 2; ++a)
#pragma unroll
                for (int b = 0; b < 2; ++b)
#pragma unroll
                    for (int m = 0; m < 4; ++m)
#pragma unroll
                        for (int n = 0; n < 2; ++n) acc[a][b][m][n] = acc[a][b][m][n] * 0.5f;
        }
#endif
        if (wr == 0) PG8_BAR;
        E(acc, cur, wr, wc, fr, fq, wid, lane);
        if (!has_next) break;
#pragma unroll
        for (int a = 0; a < 2; ++a)
#pragma unroll
            for (int b = 0; b < 2; ++b)
#pragma unroll
                for (int m = 0; m < 4; ++m)
#pragma unroll
                    for (int n = 0; n < 2; ++n) acc[a][b][m][n] = (f32x4){0.f, 0.f, 0.f, 0.f};
        cur = nxt; cA = nA; cB = nB; ++ui;
        if (wr == 1) PG8_BAR;
    }
    PG8_WAIT_V(0);
    PG8_BAR;
#undef PG8_SA
#undef PG8_FENCE
#undef PG8_SB
#undef PG8_STAGE
#undef PG8_LDA
#undef PG8_LDB
#undef PG8_MMA
#undef PG8_WAIT_V
#undef PG8_WAIT_L
#undef PG8_BAR
#undef PG8_SCHED
}
}

namespace epi {
using pg8::Unit;
__device__ __forceinline__ void st8(bf16_t* p, const f32x4 v0, const f32x4 v1) {
    u32x4 w; w.x = cvt_pk_bf16(v0[0], v0[1]); w.y = cvt_pk_bf16(v0[2], v0[3]); w.z = cvt_pk_bf16(v1[0], v1[1]); w.w = cvt_pk_bf16(v1[2], v1[3]);
    *(u32x4*)p = w;
}
__device__ __forceinline__ float sumsq8(const f32x4 a, const f32x4 b) { return (a[0] * a[0] + a[1] * a[1]) + (a[2] * a[2] + a[3] * a[3]) + (b[0] * b[0] + b[1] * b[1]) + (b[2] * b[2] + b[3] * b[3]); }
__device__ __forceinline__ f32x4 silu4(const f32x4 v) { return (f32x4){siluf_(v[0]), siluf_(v[1]), siluf_(v[2]), siluf_(v[3])}; }

template <bool KMEAN_>
__device__ __forceinline__ void qk_norm_store(const f32x4 (&acc)[2][2][4][2], const Unit& u, int wr, int wc, int fr, int fq, int wid, int lane,
                                              LAS unsigned char* scr, const float* gn, bf16_t* dst, int head0, float* kmean) {
    LAS float* P = (LAS float*)scr;
#pragma unroll
    for (int ai = 0; ai < 2; ++ai)
#pragma unroll
        for (int m = 0; m < 4; ++m)
#pragma unroll
            for (int bj = 0; bj < 2; ++bj) {
                float ss = sumsq8(acc[ai][bj][m][0], acc[ai][bj][m][1]);
                ss += __shfl_xor(ss, 16); ss += __shfl_xor(ss, 32);
                if (fq == 0) P[((ai * 128 + wr * 64 + m * 16 + fr) * 2 + bj) * 4 + wc] = ss;
                __builtin_amdgcn_sched_barrier(0);
            }
    WG_BAR();
    const f32x4 g0 = *(const f32x4*)(gn + 32 * wc + 8 * fq), g1 = *(const f32x4*)(gn + 32 * wc + 8 * fq + 4);
#pragma unroll
    for (int ai = 0; ai < 2; ++ai)
#pragma unroll
        for (int m = 0; m < 4; ++m)
#pragma unroll
            for (int bj = 0; bj < 2; ++bj) {
                const int rl = ai * 128 + wr * 64 + m * 16 + fr;
                const f32x4 p4 = *(const LAS f32x4*)&P[(rl * 2 + bj) * 4];
                const float rstd = __builtin_amdgcn_rsqf(((p4[0] + p4[1]) + (p4[2] + p4[3])) * (1.0f / 128.0f) + EPS);
                const f32x4 v0 = acc[ai][bj][m][0] * rstd * g0, v1 = acc[ai][bj][m][1] * rstd * g1;
                st8(dst + ((size_t)(head0 + bj) * SEQ + (size_t)(u.pm * 256 + rl)) * HD + 32 * wc + 8 * fq, v0, v1);
                __builtin_amdgcn_sched_barrier(0);
            }
    if (KMEAN_) {
        __builtin_amdgcn_sched_barrier(0);
#pragma unroll
        for (int bj = 0; bj < 2; ++bj)
#pragma unroll
            for (int n = 0; n < 2; ++n) {
                f32x4 c4 = (f32x4){0.f, 0.f, 0.f, 0.f};
#pragma unroll
                for (int ai = 0; ai < 2; ++ai)
#pragma unroll
                    for (int m = 0; m < 4; ++m) {
                        const int rl = ai * 128 + wr * 64 + m * 16 + fr;
                        const f32x4 p4 = *(const LAS f32x4*)&P[(rl * 2 + bj) * 4];
                        const float rstd = __builtin_amdgcn_rsqf(((p4[0] + p4[1]) + (p4[2] + p4[3])) * (1.0f / 128.0f) + EPS);
                        c4 += acc[ai][bj][m][n] * rstd;
                    }
                c4 = c4 * (n == 0 ? g0 : g1);
#pragma unroll
                for (int e = 0; e < 4; ++e) {
                    float s = c4[e];
                    s += __shfl_xor(s, 1); s += __shfl_xor(s, 2); s += __shfl_xor(s, 4); s += __shfl_xor(s, 8);
                    if (fr == 0) atomicAdd(kmean + ((size_t)(head0 + bj) * 64 + u.pm) * HD + 32 * wc + 8 * fq + 4 * n + e, s * (1.0f / 256.0f));
                }
                __builtin_amdgcn_sched_barrier(0);
            }
    }
}

struct EpiEven {
    static constexpr bool PERM = true;
#ifdef REPE
    static constexpr int REPS = REPE_EVEN;
#endif
    unsigned char* ws; float* KMEAN; const float *qn, *kn; LAS unsigned char* scr;
    __device__ __forceinline__ void operator()(const f32x4 (&acc)[2][2][4][2], const Unit& u, int wr, int wc, int fr, int fq, int wid, int lane) const {
        asm volatile("" : "+v"(fr), "+v"(fq), "+v"(lane));
        const int pn = u.pn, row0 = u.pm * 256 + wr * 64 + fr;
        bf16_t* UA = (bf16_t*)(ws + WS_UA); bf16_t* Q = (bf16_t*)(ws + WS_Q); bf16_t* K = (bf16_t*)(ws + WS_K); bf16_t* SG = (bf16_t*)(ws + WS_SG);
        if (pn < 4) {
#pragma unroll
            for (int ai = 0; ai < 2; ++ai)
#pragma unroll
                for (int m = 0; m < 4; ++m) { bf16_t* rp = UA + (size_t)(row0 + ai * 128 + m * 16) * HALFW + pn * 256 + wc * 32 + 8 * fq;
#pragma unroll
                    for (int bj = 0; bj < 2; ++bj) st8(rp + bj * 128, acc[ai][bj][m][0], acc[ai][bj][m][1]); }
        } else if (pn < 8) {
            qk_norm_store<false>(acc, u, wr, wc, fr, fq, wid, lane, scr, qn, Q, 2 * (pn - 4), nullptr);
        } else if (pn < 12) {
            qk_norm_store<true>(acc, u, wr, wc, fr, fq, wid, lane, scr, kn, K, 2 * (pn - 8), KMEAN);
        } else {
#pragma unroll
            for (int ai = 0; ai < 2; ++ai)
#pragma unroll
                for (int m = 0; m < 4; ++m) { bf16_t* rp = SG + (size_t)(row0 + ai * 128 + m * 16) * DM + (pn - 12) * 256 + wc * 32 + 8 * fq;
#pragma unroll
                    for (int bj = 0; bj < 2; ++bj) st8(rp + bj * 128, silu4(acc[ai][bj][m][0]), silu4(acc[ai][bj][m][1])); }
        }
    }
};

struct EpiOdd {
    static constexpr bool PERM = true;
#ifdef REPE
    static constexpr int REPS = REPE_ODD;
#endif
    unsigned char* ws; unsigned* KIMAX; const float *qn, *kn; LAS unsigned char* scr;
    __device__ __forceinline__ void operator()(const f32x4 (&acc)[2][2][4][2], const Unit& u, int wr, int wc, int fr, int fq, int wid, int lane) const {
        asm volatile("" : "+v"(fr), "+v"(fq), "+v"(lane));
        const int pn = u.pn, row0 = u.pm * 256 + wr * 64 + fr;
        bf16_t* Q = (bf16_t*)(ws + WS_Q); bf16_t* K = (bf16_t*)(ws + WS_K); bf16_t* QI = (bf16_t*)(ws + WS_QI); bf16_t* KI = (bf16_t*)(ws + WS_KI); bf16_t* U = (bf16_t*)(ws + WS_U); bf16_t* SG = (bf16_t*)(ws + WS_SG); float* WI = (float*)(ws + WS_WI);
        if (pn < 4) {
            qk_norm_store<false>(acc, u, wr, wc, fr, fq, wid, lane, scr, qn, Q, 2 * pn, nullptr);
        } else if (pn < 8) {
            qk_norm_store<false>(acc, u, wr, wc, fr, fq, wid, lane, scr, kn, K, 2 * (pn - 4), nullptr);
        } else if (pn < 10) {
#pragma unroll
            for (int ai = 0; ai < 2; ++ai)
#pragma unroll
                for (int m = 0; m < 4; ++m) { bf16_t* rp = QI + (size_t)(row0 + ai * 128 + m * 16) * 512 + (pn - 8) * 256 + wc * 32 + 8 * fq;
#pragma unroll
                    for (int bj = 0; bj < 2; ++bj) {
#ifdef PROBE_QITRUNC
                        u32x4 w_; w_.x = cvt_pk_bf16(acc[ai][bj][m][0][0], acc[ai][bj][m][0][1]) & 0xFFFEFFFEu; w_.y = cvt_pk_bf16(acc[ai][bj][m][0][2], acc[ai][bj][m][0][3]) & 0xFFFEFFFEu; w_.z = cvt_pk_bf16(acc[ai][bj][m][1][0], acc[ai][bj][m][1][1]) & 0xFFFEFFFEu; w_.w = cvt_pk_bf16(acc[ai][bj][m][1][2], acc[ai][bj][m][1][3]) & 0xFFFEFFFEu; *(u32x4*)(rp + bj * 128) = w_;
#else
                        st8(rp + bj * 128, acc[ai][bj][m][0], acc[ai][bj][m][1]);
#endif
                    } }
        } else if (pn == 10) {
            if (wc < 2) {
                float mx = 0.f;
#pragma unroll
                for (int ai = 0; ai < 2; ++ai)
#pragma unroll
                    for (int m = 0; m < 4; ++m) {
                        st8(KI + (size_t)(row0 + ai * 128 + m * 16) * 64 + wc * 32 + 8 * fq, acc[ai][0][m][0], acc[ai][0][m][1]);
                        mx = fmaxf(mx, sumsq8(acc[ai][0][m][0], acc[ai][0][m][1]));
                    }
                mx = fmaxf(mx, __shfl_xor(mx, 1)); mx = fmaxf(mx, __shfl_xor(mx, 2)); mx = fmaxf(mx, __shfl_xor(mx, 4)); mx = fmaxf(mx, __shfl_xor(mx, 8));
                if (fr == 0) atomicMax(KIMAX + wc * 4 + fq, __float_as_uint(mx));
            } else if (wc == 2 && fq == 0) {
                const float s = 0.35355339059327373f;
#pragma unroll
                for (int ai = 0; ai < 2; ++ai)
#pragma unroll
                    for (int m = 0; m < 4; ++m) { float* wp = WI + (size_t)(row0 + ai * 128 + m * 16) * 8;
                        *(f32x4*)wp = acc[ai][0][m][0] * s; *(f32x4*)(wp + 4) = acc[ai][0][m][1] * s; }
            }
        } else if (pn < 19) {
            const int j = pn - 11;
#pragma unroll
            for (int ai = 0; ai < 2; ++ai)
#pragma unroll
                for (int m = 0; m < 4; ++m) {
                    f32x4 u0, u1;
#pragma unroll
                    for (int e = 0; e < 4; ++e) { u0[e] = acc[ai][0][m][0][e] * sigmoidf_(acc[ai][1][m][0][e]); u1[e] = acc[ai][0][m][1][e] * sigmoidf_(acc[ai][1][m][1][e]); }
                    st8(U + (size_t)(row0 + ai * 128 + m * 16) * HALFW + j * 128 + wc * 32 + 8 * fq, u0, u1);
                }
        } else {
#pragma unroll
            for (int ai = 0; ai < 2; ++ai)
#pragma unroll
                for (int m = 0; m < 4; ++m) { bf16_t* rp = SG + (size_t)(row0 + ai * 128 + m * 16) * DM + (pn - 19) * 256 + wc * 32 + 8 * fq;
#pragma unroll
                    for (int bj = 0; bj < 2; ++bj) st8(rp + bj * 128, silu4(acc[ai][bj][m][0]), silu4(acc[ai][bj][m][1])); }
        }
    }
};

struct EpiVT {
    static constexpr bool PERM = true;
#ifdef REPE
    static constexpr int REPS = REPE_VT;
#endif
    bf16_t* VT;
    __device__ __forceinline__ void operator()(const f32x4 (&acc)[2][2][4][2], const Unit& u, int wr, int wc, int fr, int fq, int wid, int lane) const {
        asm volatile("" : "+v"(fr), "+v"(fq), "+v"(lane));
        const int row0 = u.pm * 256 + wr * 64 + fr;
#pragma unroll
        for (int ai = 0; ai < 2; ++ai)
#pragma unroll
            for (int m = 0; m < 4; ++m) { bf16_t* rp = VT + (size_t)(row0 + ai * 128 + m * 16) * SEQ + u.pn * 256 + wc * 32 + 8 * fq;
#pragma unroll
                for (int bj = 0; bj < 2; ++bj) st8(rp + bj * 128, acc[ai][bj][m][0], acc[ai][bj][m][1]); }
    }
};

struct EpiPool {
    static constexpr bool PERM = true;
#ifdef REPE
    static constexpr int REPS = REPE_POOL;
#endif
    const float* pscale; const bf16_t* SG; bf16_t* YG;
    __device__ __forceinline__ void operator()(const f32x4 (&acc)[2][2][4][2], const Unit& u, int wr, int wc, int fr, int fq, int wid, int lane) const {
        asm volatile("" : "+v"(fr), "+v"(fq), "+v"(lane));
        const int row0 = (u.pm & 63) * 256 + wr * 64 + fr;
#pragma unroll
        for (int bj = 0; bj < 2; ++bj) {
            const int col = u.pn * 256 + bj * 128 + wc * 32 + 8 * fq;
            u32x4 gv[1][2][4];
#pragma unroll
            for (int ai = 0; ai < 2; ++ai)
#pragma unroll
                for (int m = 0; m < 4; ++m) gv[0][ai][m] = *(const u32x4*)(SG + (size_t)(row0 + ai * 128 + m * 16) * DM + col);
            const f32x4 p0 = *(const f32x4*)(pscale + col), p1 = *(const f32x4*)(pscale + col + 4);
            __builtin_amdgcn_sched_barrier(0);
#pragma unroll
            for (int ai = 0; ai < 2; ++ai)
#pragma unroll
                for (int m = 0; m < 4; ++m) { const size_t o = (size_t)(row0 + ai * 128 + m * 16) * DM + col;
                    const u32x4 g = gv[0][ai][m];
                    const f32x4 g0 = (f32x4){bflo(g.x), bfhi(g.x), bflo(g.y), bfhi(g.y)}, g1 = (f32x4){bflo(g.z), bfhi(g.z), bflo(g.w), bfhi(g.w)};
                    st8(YG + o, acc[ai][bj][m][0] * p0 * g0, acc[ai][bj][m][1] * p1 * g1); }
            __builtin_amdgcn_sched_barrier(0);
        }
    }
};

template <bool IN_BF, bool OUT_BF>
struct EpiOut {
    static constexpr bool PERM = true;
#ifdef REPE
    static constexpr int REPS = REPE_OUT;
#endif
    const void* xin; void* xout; const float* gate; LAS unsigned char* scr;
    __device__ __forceinline__ void operator()(const f32x4 (&acc)[2][2][4][2], const Unit& u, int wr, int wc, int fr, int fq, int wid, int lane) const {
        asm volatile("" : "+v"(fr), "+v"(fq), "+v"(lane));
        LAS unsigned char* st = scr + wid * 2304;
        const int lr = lane >> 3, lp = lane & 7;
        const int rowb = u.pm * 256 + wr * 64, colb = u.pn * 256 + 64 * wc;
        f32x4 g[2][2];
#pragma unroll
        for (int bj = 0; bj < 2; ++bj)
#pragma unroll
            for (int n = 0; n < 2; ++n) g[bj][n] = *(const f32x4*)(gate + colb + 32 * bj + 8 * fq + 4 * n);
        u32x4 xa[4], xb[4], xc[4];
#define EO_RT(k) (rowb + ((k) >> 2) * 128 + ((k) & 3) * 16)
#define EO_LD(buf, k) do { if (IN_BF) { _Pragma("unroll") for (int j = 0; j < 2; ++j) buf[j] = *(const u32x4*)((const bf16_t*)xin + (size_t)(EO_RT(k) + lr + 8 * j) * DM + colb + 8 * lp); } \
        else { _Pragma("unroll") for (int q = 0; q < 4; ++q) buf[q] = *(const u32x4*)((const float*)xin + (size_t)(EO_RT(k) + fr) * DM + colb + 32 * (q >> 1) + 8 * fq + 4 * (q & 1)); } \
        __builtin_amdgcn_sched_barrier(0); } while (0)
#define EO_PROC(buf, k) do { f32x4 v[2][2]; \
        if (IN_BF) { _Pragma("unroll") for (int j = 0; j < 2; ++j) *(LAS u32x4*)(st + (lr + 8 * j) * 144 + 16 * lp) = buf[j]; \
            asm volatile("" ::: "memory"); \
            _Pragma("unroll") for (int bj = 0; bj < 2; ++bj) { const u32x4 xf = *(const LAS u32x4*)(st + fr * 144 + 16 * (4 * bj + fq)); \
                v[bj][0] = (f32x4){bflo(xf.x), bfhi(xf.x), bflo(xf.y), bfhi(xf.y)} + g[bj][0] * acc[(k) >> 2][bj][(k) & 3][0]; v[bj][1] = (f32x4){bflo(xf.z), bfhi(xf.z), bflo(xf.w), bfhi(xf.w)} + g[bj][1] * acc[(k) >> 2][bj][(k) & 3][1]; } \
            asm volatile("" ::: "memory"); } \
        else { _Pragma("unroll") for (int bj = 0; bj < 2; ++bj) _Pragma("unroll") for (int n = 0; n < 2; ++n) { const u32x4 xq = buf[2 * bj + n]; \
                v[bj][n] = (f32x4){__uint_as_float(xq.x), __uint_as_float(xq.y), __uint_as_float(xq.z), __uint_as_float(xq.w)} + g[bj][n] * acc[(k) >> 2][bj][(k) & 3][n]; } } \
        if (OUT_BF) { _Pragma("unroll") for (int bj = 0; bj < 2; ++bj) { u32x4 w; w.x = cvt_pk_bf16(v[bj][0][0], v[bj][0][1]); w.y = cvt_pk_bf16(v[bj][0][2], v[bj][0][3]); w.z = cvt_pk_bf16(v[bj][1][0], v[bj][1][1]); w.w = cvt_pk_bf16(v[bj][1][2], v[bj][1][3]); \
                *(LAS u32x4*)(st + fr * 144 + 16 * (4 * bj + fq)) = w; } \
            asm volatile("" ::: "memory"); \
            _Pragma("unroll") for (int j = 0; j < 2; ++j) { const u32x4 r = *(const LAS u32x4*)(st + (lr + 8 * j) * 144 + 16 * lp); *(u32x4*)((bf16_t*)xout + (size_t)(EO_RT(k) + lr + 8 * j) * DM + colb + 8 * lp) = r; } \
            asm volatile("" ::: "memory"); } \
        else { _Pragma("unroll") for (int bj = 0; bj < 2; ++bj) { *(LAS f32x4*)(st + fr * 144 + 32 * fq) = v[bj][0]; *(LAS f32x4*)(st + fr * 144 + 32 * fq + 16) = v[bj][1]; \
                asm volatile("" ::: "memory"); \
                _Pragma("unroll") for (int j = 0; j < 2; ++j) { const f32x4 r = *(const LAS f32x4*)(st + (lr + 8 * j) * 144 + 16 * lp); *(f32x4*)((float*)xout + (size_t)(EO_RT(k) + lr + 8 * j) * DM + colb + 32 * bj + 4 * lp) = r; } \
                asm volatile("" ::: "memory"); } } \
        __builtin_amdgcn_sched_barrier(0); } while (0)
        EO_LD(xa, 0); EO_LD(xb, 1); EO_LD(xc, 2); EO_PROC(xa, 0); EO_LD(xa, 3); EO_PROC(xb, 1); EO_LD(xb, 4); EO_PROC(xc, 2); EO_LD(xc, 5); EO_PROC(xa, 3); EO_LD(xa, 6); EO_PROC(xb, 4); EO_LD(xb, 7); EO_PROC(xc, 5); EO_PROC(xa, 6); EO_PROC(xb, 7);
#undef EO_RT
#undef EO_LD
#undef EO_PROC
    }
};
#ifdef REP7B
struct EpiOutProbe {
    static constexpr bool PERM = true;
    const float* xin; float* xout; const float* gate; int mode;
    __device__ __forceinline__ void operator()(const f32x4 (&acc)[2][2][4][2], const Unit& u, int wr, int wc, int fr, int fq, int wid, int lane) const {
        asm volatile("" : "+v"(fr), "+v"(fq), "+v"(lane));
        const size_t o0 = (size_t)(u.pm * 256 + wr * 64 + fr) * DM + u.pn * 256 + wc * 32 + 8 * fq;
        const float* xi = xin + o0; float* xo = xout + o0;
        f32x4 sum = (f32x4){0.f, 0.f, 0.f, 0.f};
#pragma unroll
        for (int b = 0; b < 4; ++b) {
            f32x4 xa[4][2];
#pragma unroll
            for (int m = 0; m < 4; ++m) { xa[m][0] = (f32x4){0.f, 0.f, 0.f, 0.f}; xa[m][1] = xa[m][0]; }
            if (mode & 1) {
#pragma unroll
                for (int m = 0; m < 4; ++m) { const float* p_ = xi + (size_t)((b & 1) * 128 + m * 16) * DM + (b >> 1) * 128; xa[m][0] = *(const f32x4*)p_; xa[m][1] = *(const f32x4*)(p_ + 4); }
            }
            __builtin_amdgcn_sched_barrier(0);
#pragma unroll
            for (int m = 0; m < 4; ++m) { float* p_ = xo + (size_t)((b & 1) * 128 + m * 16) * DM + (b >> 1) * 128;
                const f32x4 v0 = xa[m][0] + acc[b & 1][b >> 1][m][0], v1 = xa[m][1] + acc[b & 1][b >> 1][m][1];
                if (mode & 8) { const int k_ = b * 8 + m * 2;
                    float* q0 = xout + (size_t)(u.pm * 256 + 32 * wid + 8 * (k_ >> 3) + (lane >> 3)) * DM + u.pn * 256 + (k_ & 7) * 32 + (lane & 7) * 4;
                    float* q1 = xout + (size_t)(u.pm * 256 + 32 * wid + 8 * ((k_ + 1) >> 3) + (lane >> 3)) * DM + u.pn * 256 + ((k_ + 1) & 7) * 32 + (lane & 7) * 4;
                    *(f32x4*)q0 = v0; *(f32x4*)q1 = v1; }
                else if (mode & 4) st8((bf16_t*)xout + (o0 + (size_t)((b & 1) * 128 + m * 16) * DM + (b >> 1) * 128), v0, v1); else if (mode & 2) { *(f32x4*)p_ = v0; *(f32x4*)(p_ + 4) = v1; } else sum += v0 * v1; }
            __builtin_amdgcn_sched_barrier(0);
        }
        if (!(mode & 14) && sum[0] + sum[1] + sum[2] + sum[3] == 1.2345e38f) xo[0] = sum[0];
    }
};
#endif
}

struct Frame {
    LAS unsigned char* lds;
    unsigned* ctl;
    int tid, lane, wave, G, bid;
};
__device__ __forceinline__ float wave_sum(float v) {
#pragma unroll
    for (int o = 1; o < 64; o <<= 1) v += __shfl_xor(v, o);
    return v;
}

struct MapId { __device__ __forceinline__ int operator()(int n) const { return n; } };
__device__ __forceinline__ int tile_sigma(int n) { return (n & ~255) | (((n >> 5) & 3) << 6) | (((n >> 7) & 1) << 5) | (n & 31); }
struct MapSig { __device__ __forceinline__ int operator()(int n) const { return tile_sigma(n); } };
struct MapEven { __device__ __forceinline__ int operator()(int n) const { return n < 3072 ? n : (n < 5120 ? n + 1024 : n - 2048); } };
struct MapOdd { __device__ __forceinline__ int operator()(int n) const {
    if (n < 2048) return n;
    if (n < 2560) return 3072 + (n - 2048);
    if (n < 2816) { const int r = n - 2560; return r < 64 ? 3592 + r : (r < 72 ? 3584 + (r - 64) : -1); }
    if (n < 4864) { const int r = n - 2816, j = r >> 8, i = r & 255; return i < 128 ? 3656 + 128 * j + i : 4680 + 128 * j + (i - 128); }
    if (n < 6912) return 5704 + (n - 4864);
    return 2048 + (n - 6912); } };
template <class F>
__device__ __forceinline__ void transpose_item(const float* W, int K, int N, bf16_t* WT, LAS float* scr, int item, int ndb, int lane, F srccol) {
    const int kb = item / ndb, nb = item % ndb, k0 = 64 * kb, n0 = 32 * nb;
    const int sc = srccol(n0 + (lane & 31));
    float tv[32];
#pragma unroll
    for (int i = 0; i < 32; ++i) { const int kk = 2 * i + (lane >> 5); tv[i] = W[(size_t)(k0 + kk) * N + (sc >= 0 ? sc : 0)]; }
#pragma unroll
    for (int i = 0; i < 32; ++i) { const int kk = 2 * i + (lane >> 5); scr[kk * 33 + (lane & 31)] = sc >= 0 ? tv[i] : 0.f; }
    LDS_WAIT(); asm volatile("" ::: "memory");
    const int c = lane & 7;
#pragma unroll
    for (int j = 0; j < 4; ++j) { const int n = (lane >> 3) + 8 * j; const LAS float* s = scr + (8 * c) * 33 + n;
        u32x4 o; o.x = cvt_pk_bf16(s[0 * 33], s[1 * 33]); o.y = cvt_pk_bf16(s[2 * 33], s[3 * 33]); o.z = cvt_pk_bf16(s[4 * 33], s[5 * 33]); o.w = cvt_pk_bf16(s[6 * 33], s[7 * 33]);
        *(u32x4*)(WT + (size_t)(n0 + n) * K + k0 + 8 * c) = o; }
    LDS_WAIT(); asm volatile("" ::: "memory");
}
__device__ __forceinline__ void phase_p0a(Frame& F, const float* cvec, const float* ada_w, const float* w_out, const float* ev_w, const float* pool_w, const float* od_w, unsigned char* ws) {
    LAS float* sil = (LAS float*)(F.lds + SCR_OFF);
    float* modp = (float*)(ws + WS_MODP);
    for (int it = F.bid; it < 4 * 8 * 12; it += F.G) {
        const int jb = it % 12, ch = (it / 12) % 8, l = it / 96;
        __syncthreads();
        if (F.tid < 256) sil[F.tid] = siluf_(cvec[ch * 256 + F.tid]);
        __syncthreads();
        const float* wp = ada_w + ((size_t)l * DM + ch * 256) * 6144 + jb * 512 + F.tid;
        float a0 = 0.f, a1 = 0.f, a2 = 0.f, a3 = 0.f;
        for (int i = 0; i < 256; i += 16) {
            float v[16];
#pragma unroll
            for (int k = 0; k < 16; ++k) v[k] = wp[(size_t)(i + k) * 6144];
#pragma unroll
            for (int k = 0; k < 16; k += 4) { a0 = fmaf(sil[i + k], v[k], a0); a1 = fmaf(sil[i + k + 1], v[k + 1], a1); a2 = fmaf(sil[i + k + 2], v[k + 2], a2); a3 = fmaf(sil[i + k + 3], v[k + 3], a3); }
        }
        modp[((size_t)ch * 4 + l) * 6144 + jb * 512 + F.tid] = (a0 + a1) + (a2 + a3);
    }
    __syncthreads();
    LAS float* scr = (LAS float*)(F.lds + F.wave * 16384);
    const int gw = F.bid * 8 + F.wave, NGW = F.G * 8;
    constexpr int I_EV = 32 * 192, I_OD = 32 * 248, I_OUT = 32 * 64, I_PW = 4 * 8;
    constexpr int NIT = 2 * I_EV + 2 * I_OD + 4 * I_OUT + 8 * I_PW;
    for (int it = gw; it < NIT; it += NGW) {
        int r = it;
        if (r < 2 * I_EV) { const int e = r / I_EV; transpose_item(ev_w + (size_t)e * DM * EV_N, DM, EV_N, (bf16_t*)(ws + WS_WEV) + (size_t)e * EV_N * DM, scr, r % I_EV, 192, F.lane, MapEven()); continue; } r -= 2 * I_EV;
        if (r < 2 * I_OD) { const int e = r / I_OD; transpose_item(od_w + (size_t)e * DM * OD_SRC_N, DM, OD_SRC_N, (bf16_t*)(ws + WS_WOD) + (size_t)e * OD_N * DM, scr, r % I_OD, 248, F.lane, MapOdd()); continue; } r -= 2 * I_OD;
        if (r < 4 * I_OUT) { const int e = r / I_OUT; transpose_item(w_out + (size_t)e * DM * DM, DM, DM, (bf16_t*)(ws + WS_WOUT) + (size_t)e * DM * DM, scr, r % I_OUT, 64, F.lane, MapSig()); continue; } r -= 4 * I_OUT;
        { const int e = r / I_PW; transpose_item(pool_w + (size_t)e * 65536, 256, 256, (bf16_t*)(ws + WS_PWT) + (size_t)e * 65536, scr, r % I_PW, 8, F.lane, MapId()); }
    }
}
__device__ __forceinline__ void phase_p0b(Frame& F, const float* ada_b, unsigned char* ws) {
    const float* modp = (const float*)(ws + WS_MODP); float* modf = (float*)(ws + WS_MODF);
    for (int i = F.bid * 512 + F.tid; i < 4 * 6144; i += F.G * 512) {
        float s = ada_b[i];
#pragma unroll
        for (int c = 0; c < 8; ++c) s += modp[(size_t)c * 4 * 6144 + i];
        modf[i] = s;
    }
}

template <bool BF>
__device__ __forceinline__ void phase_norm(Frame& F, const void* xin_, const float* norm_g, const float* mod, bf16_t* H) {
    if (BF) {
        const int gw = F.bid * 8 + F.wave, NGW = F.G * 8;
        const bf16_t* xin = (const bf16_t*)xin_;
        f32x4 gs[8], sh[8];
        { f32x4 g_[8], sc_[8];
#pragma unroll
          for (int j = 0; j < 8; ++j) { const int c = 8 * F.lane + 512 * (j >> 1) + 4 * (j & 1); g_[j] = *(const f32x4*)(norm_g + c); sc_[j] = *(const f32x4*)(mod + DM + c); sh[j] = *(const f32x4*)(mod + c); }
          __builtin_amdgcn_sched_barrier(0);
#pragma unroll
          for (int j = 0; j < 8; ++j) gs[j] = g_[j] * (sc_[j] + 1.0f); }
        u32x4 w0[4], w1[4], w2[4];
        { const int r0 = gw < SEQ ? gw : SEQ - 1, r1 = gw + NGW < SEQ ? gw + NGW : SEQ - 1;
          const u32x4* xa = (const u32x4*)(xin + (size_t)r0 * DM) + F.lane; const u32x4* xb = (const u32x4*)(xin + (size_t)r1 * DM) + F.lane;
#pragma unroll
          for (int j = 0; j < 4; ++j) { w0[j] = xa[64 * j]; w1[j] = xb[64 * j]; } }
        for (int row = gw; row < SEQ; row += NGW) {
            const int rn = row + 2 * NGW < SEQ ? row + 2 * NGW : row;
            { const u32x4* xr = (const u32x4*)(xin + (size_t)rn * DM) + F.lane;
#pragma unroll
              for (int j = 0; j < 4; ++j) w2[j] = xr[64 * j]; }
            f32x4 v[8];
#pragma unroll
            for (int j = 0; j < 4; ++j) { v[2 * j] = (f32x4){bflo(w0[j].x), bfhi(w0[j].x), bflo(w0[j].y), bfhi(w0[j].y)}; v[2 * j + 1] = (f32x4){bflo(w0[j].z), bfhi(w0[j].z), bflo(w0[j].w), bfhi(w0[j].w)}; }
            float s = 0.f;
#pragma unroll
            for (int j = 0; j < 8; ++j) s += (v[j][0] * v[j][0] + v[j][1] * v[j][1]) + (v[j][2] * v[j][2] + v[j][3] * v[j][3]);
            const float rstd = __builtin_amdgcn_rsqf(wave_sum(s) * (1.0f / DM) + EPS);
            u32x4* op = (u32x4*)(H + (size_t)row * DM) + F.lane;
#pragma unroll
            for (int j = 0; j < 4; ++j) { const f32x4 y0 = v[2 * j] * rstd * gs[2 * j] + sh[2 * j], y1 = v[2 * j + 1] * rstd * gs[2 * j + 1] + sh[2 * j + 1];
                u32x4 w; w.x = cvt_pk_bf16(y0[0], y0[1]); w.y = cvt_pk_bf16(y0[2], y0[3]); w.z = cvt_pk_bf16(y1[0], y1[1]); w.w = cvt_pk_bf16(y1[2], y1[3]); op[64 * j] = w; }
#pragma unroll
            for (int j = 0; j < 4; ++j) { w0[j] = w1[j]; w1[j] = w2[j]; }
        }
        return;
    }
    const float* xin = (const float*)xin_;
    f32x4 gs[8], sh[8];
    { f32x4 g_[8], sc_[8];
#pragma unroll
      for (int j = 0; j < 8; ++j) { const int c = 4 * F.lane + 256 * j; g_[j] = *(const f32x4*)(norm_g + c); sc_[j] = *(const f32x4*)(mod + DM + c); sh[j] = *(const f32x4*)(mod + c); }
      __builtin_amdgcn_sched_barrier(0);
#pragma unroll
      for (int j = 0; j < 8; ++j) gs[j] = g_[j] * (sc_[j] + 1.0f); }
    const int gw = F.bid * 8 + F.wave, NGW = F.G * 8;
    f32x4 v[8], vn[8];
    if (gw < SEQ) { const f32x4* xr = (const f32x4*)(xin + (size_t)gw * DM) + F.lane;
#pragma unroll
        for (int j = 0; j < 8; ++j) v[j] = xr[64 * j]; }
    for (int row = gw; row < SEQ; row += NGW) {
        const int rn = row + NGW < SEQ ? row + NGW : row;
        { const f32x4* xr = (const f32x4*)(xin + (size_t)rn * DM) + F.lane;
#pragma unroll
          for (int j = 0; j < 8; ++j) vn[j] = xr[64 * j]; }
        float s = 0.f;
#pragma unroll
        for (int j = 0; j < 8; ++j) s += (v[j][0] * v[j][0] + v[j][1] * v[j][1]) + (v[j][2] * v[j][2] + v[j][3] * v[j][3]);
        const float rstd = __builtin_amdgcn_rsqf(wave_sum(s) * (1.0f / DM) + EPS);
        u32x2* op = (u32x2*)(H + (size_t)row * DM) + F.lane;
#pragma unroll
        for (int j = 0; j < 8; ++j) { const f32x4 y = v[j] * rstd * gs[j] + sh[j]; u32x2 w; w.x = cvt_pk_bf16(y[0], y[1]); w.y = cvt_pk_bf16(y[2], y[3]); op[64 * j] = w; }
#pragma unroll
        for (int j = 0; j < 8; ++j) v[j] = vn[j];
    }
}

template <int W>
__device__ __forceinline__ void pool_d_item(const bf16_t* UA, bf16_t* D, int t, int g, int c8) {
    const int n = (t + 1) < W ? (t + 1) : W;
    u32x4 uw[W];
#pragma unroll
    for (int j = 0; j < W; ++j) uw[j] = *(const u32x4*)(UA + (size_t)(j < n ? t - j : t) * HALFW + c8 * 8);
    float a[8];
#pragma unroll
    for (int e = 0; e < 8; ++e) a[e] = 0.f;
#pragma unroll
    for (int j = 0; j < W; ++j) { const float wj = j < n ? 1.0f : 0.0f; const u32x4 u = uw[j];
        a[0] = fmaf(wj, bflo(u.x), a[0]); a[1] = fmaf(wj, bfhi(u.x), a[1]); a[2] = fmaf(wj, bflo(u.y), a[2]); a[3] = fmaf(wj, bfhi(u.y), a[3]);
        a[4] = fmaf(wj, bflo(u.z), a[4]); a[5] = fmaf(wj, bfhi(u.z), a[5]); a[6] = fmaf(wj, bflo(u.w), a[6]); a[7] = fmaf(wj, bfhi(u.w), a[7]); }
    const float inv = 1.0f / (float)n; const u32x4 u0 = uw[0];
    u32x4 o;
    o.x = cvt_pk_bf16(a[0] * inv - bflo(u0.x), a[1] * inv - bfhi(u0.x)); o.y = cvt_pk_bf16(a[2] * inv - bflo(u0.y), a[3] * inv - bfhi(u0.y));
    o.z = cvt_pk_bf16(a[4] * inv - bflo(u0.z), a[5] * inv - bfhi(u0.z)); o.w = cvt_pk_bf16(a[6] * inv - bflo(u0.w), a[7] * inv - bfhi(u0.w));
    *(u32x4*)(D + ((size_t)g * SEQ + t) * 256 + (c8 & 31) * 8) = o;
}
__device__ __forceinline__ void phase_pool_d(Frame& F, const bf16_t* UA, bf16_t* D) {
    const int gw = F.bid * 8 + F.wave, NGW = F.G * 8;
    for (int it = gw; it < (SEQ / 2) * 4; it += NGW) {
        const int g = it & 3, t = 2 * (it >> 2) + (F.lane >> 5), c8 = g * 32 + (F.lane & 31);
        if (g == 0) pool_d_item<2>(UA, D, t, g, c8); else if (g == 1) pool_d_item<4>(UA, D, t, g, c8); else if (g == 2) pool_d_item<8>(UA, D, t, g, c8); else pool_d_item<16>(UA, D, t, g, c8);
    }
}

__device__ __forceinline__ bool better_(float av, int ai, float bv, int bi) { return av > bv || (av == bv && ai < bi); }
__device__ __forceinline__ void top3_insert(float v, int i, float& v0, int& i0, float& v1, int& i1, float& v2, int& i2) {
    const bool b0 = better_(v, i, v0, i0), b1 = better_(v, i, v1, i1), b2 = better_(v, i, v2, i2);
    const float n2 = b1 ? v1 : (b2 ? v : v2); const int m2 = b1 ? i1 : (b2 ? i : i2);
    const float n1 = b0 ? v0 : (b1 ? v : v1); const int m1 = b0 ? i0 : (b1 ? i : i1);
    const float n0 = b0 ? v : v0; const int m0 = b0 ? i : i0;
    v0 = n0; i0 = m0; v1 = n1; i1 = m1; v2 = n2; i2 = m2;
}
__device__ __forceinline__ void phase_top3(Frame& F, const bf16_t* Q, const float* KMEAN, unsigned* cnt, unsigned* LIST, float* PARTML, float knb) {
    const int gw = F.bid * 8 + F.wave, NGW = F.G * 8, r32 = F.lane & 31, hi = F.lane >> 5;
    for (int it = gw; it < 512 * 8; it += NGW) {
        const int tt = it >> 3, h = it & 7, own = tt >> 3;
        if (own == 0) continue;
        const int t = 32 * tt + r32;
        bf16x8 qr[8];
#pragma unroll
        for (int s = 0; s < 8; ++s) qr[s] = *(const bf16x8*)(Q + ((size_t)h * SEQ + t) * HD + 16 * s + 8 * hi);
        float v0 = NEG_INF, v1 = NEG_INF, v2 = NEG_INF; int i0 = 1000, i1 = 1001, i2 = 1002;
        const int nbt = own > 32 ? 2 : 1;
        for (int bt = 0; bt < nbt; ++bt) {
            f32x16 S = {};
            const float* kp = KMEAN + ((size_t)h * 64 + 32 * bt + r32) * HD + 8 * hi;
            f32x4 ka_[8], kb_[8];
#pragma unroll
            for (int s = 0; s < 8; ++s) { ka_[s] = *(const f32x4*)(kp + 16 * s); kb_[s] = *(const f32x4*)(kp + 16 * s + 4); }
            __builtin_amdgcn_sched_barrier(0);
#pragma unroll
            for (int s = 0; s < 8; ++s) {
                const f32x4 a = ka_[s], b = kb_[s];
                u32x4 wh; wh.x = cvt_pk_bf16(a[0], a[1]); wh.y = cvt_pk_bf16(a[2], a[3]); wh.z = cvt_pk_bf16(b[0], b[1]); wh.w = cvt_pk_bf16(b[2], b[3]);
                u32x4 wl; wl.x = cvt_pk_bf16(a[0] - bflo(wh.x), a[1] - bfhi(wh.x)); wl.y = cvt_pk_bf16(a[2] - bflo(wh.y), a[3] - bfhi(wh.y));
                wl.z = cvt_pk_bf16(b[0] - bflo(wh.z), b[1] - bfhi(wh.z)); wl.w = cvt_pk_bf16(b[2] - bflo(wh.w), b[3] - bfhi(wh.w));
                S = __builtin_amdgcn_mfma_f32_32x32x16_bf16(*(bf16x8*)&wh, qr[s], S, 0, 0, 0);
                S = __builtin_amdgcn_mfma_f32_32x32x16_bf16(*(bf16x8*)&wl, qr[s], S, 0, 0, 0);
            }
#pragma unroll
            for (int r = 0; r < 16; ++r) { const int blk = 32 * bt + crow(r, hi); const float v = blk < own ? S[r] : NEG_INF; top3_insert(v, blk, v0, i0, v1, i1, v2, i2); }
        }
        { const float pv0 = __shfl_xor(v0, 32), pv1 = __shfl_xor(v1, 32), pv2 = __shfl_xor(v2, 32); const int pi0 = __shfl_xor(i0, 32), pi1 = __shfl_xor(i1, 32), pi2 = __shfl_xor(i2, 32);
          top3_insert(pv0, pi0, v0, i0, v1, i1, v2, i2); top3_insert(pv1, pi1, v0, i0, v1, i1, v2, i2); top3_insert(pv2, pi2, v0, i0, v1, i1, v2, i2); }
        float ss = 0.f;
#pragma unroll
        for (int s = 0; s < 8; ++s)
#pragma unroll
            for (int e_ = 0; e_ < 8; ++e_) { const float v = bf2f((unsigned short)qr[s][e_]); ss = fmaf(v, v, ss); }
        ss += __shfl_xor(ss, 32);
        const float rowb = sqrtf(ss) * knb, sl = exp2f(-(float)(h + 1)) / SCALE;
        if (hi == 0) {
            const int nv = own < 3 ? own : 3;
            const int idx3[3] = {i0, i1, i2};
            int tt = t; asm volatile("" : "+v"(tt));
#pragma unroll
            for (int r = 0; r < 3; ++r) if (r < nv) {
                const int ib = idx3[r], dmin = tt - (256 * ib + 255);
                if ((2.0f * rowb - sl * (float)dmin) * C2 < -48.0f) { float ne_ = -1e30f, ze_ = 0.f; asm volatile("" : "+v"(ne_), "+v"(ze_)); *(f32x2*)(PARTML + (((size_t)h * SEQ + tt) * 3 + r) * 2) = (f32x2){ne_, ze_}; }
                else { const unsigned s = atomicAdd(cnt + (h * 64 + ib) * 16, 1u); LIST[((size_t)h * 64 + ib) * SEQ + s] = ((unsigned)tt << 2) | (unsigned)r; }
            }
        }
    }
}

namespace att {
constexpr int KPITCH = 272, VPITCH = 136, KBUFB = 64 * KPITCH, VBUFB = 128 * VPITCH, BUFB = KBUFB + VBUFB;
static_assert(2 * BUFB <= RING_BYTES, "lds");
constexpr float ATT_CUT = -48.0f;
constexpr int ATT_SCR = 2 * KBUFB + 3 * VBUFB;
template <int MODE>
__device__ __forceinline__ void attn_core(LAS unsigned char* lds, const bf16_t* Kh, const bf16_t* VTh, const bf16_t* qptr, int t, int j0, int j1, int jact,
                                          float sl, const unsigned short* mrow, float knb, f32x16 (&o)[4], float& m_out, float& l_out) {
    constexpr bool DESC = (MODE == 0);
    const int tid = opaque_tid(), lane = tid & 63, r32 = lane & 31, hi = lane >> 5, wid = __builtin_amdgcn_readfirstlane(tid >> 6);
    const bool lag = (MODE != 0) && wid >= 4;
    bf16x8 qr[8];
#pragma unroll
    for (int d0 = 0; d0 < 8; ++d0) qr[d0] = *(const bf16x8*)(qptr + 16 * d0 + 8 * hi);
    float rowb = 0.f;
    if (DESC) {
        float ss = 0.f;
#pragma unroll
        for (int d0 = 0; d0 < 8; ++d0)
#pragma unroll
            for (int e = 0; e < 8; ++e) { const float v = bf2f((unsigned short)qr[d0][e]); ss = fmaf(v, v, ss); }
        ss += __shfl_xor(ss, 32);
        rowb = sqrtf(ss) * knb;
    }
#pragma unroll
    for (int d0 = 0; d0 < 4; ++d0) o[d0] = f32x16{};
    float m = -1e30f, l = 0.f;
    const int nt = j1 - j0, jfirst = DESC ? j1 - 1 : j0;
    LAS unsigned char* Kr = lds; LAS unsigned char* Vr = lds + 2 * KBUFB;
    LAS int* donef = (LAS int*)(lds + ATT_SCR);
    bf16x8 sk0, sk1, sv0, sv1;
#define LOADKV(j_) do { const bf16_t* kp_ = Kh + (size_t)(64 * (j_) + (tid >> 3)) * HD + (tid & 7) * 8; sk0 = *(const bf16x8*)kp_; sk1 = *(const bf16x8*)(kp_ + 64); \
        const bf16_t* vp_ = VTh + (size_t)(tid >> 3) * SEQ + 64 * (j_) + (tid & 7) * 8; sv0 = *(const bf16x8*)vp_; sv1 = *(const bf16x8*)(vp_ + (size_t)64 * SEQ); } while (0)
#define WRITEKV(kb_, vb_) do { LAS unsigned char* kd_ = Kr + (kb_) * KBUFB + (tid >> 3) * KPITCH + (tid & 7) * 16; *(LAS bf16x8*)kd_ = sk0; *(LAS bf16x8*)(kd_ + 128) = sk1; \
        LAS unsigned char* vd_ = Vr + (vb_) * VBUFB + (tid >> 3) * VPITCH + (tid & 7) * 16; \
        *(LAS s16x4*)vd_ = __builtin_shufflevector(sv0, sv0, 0, 1, 2, 3); *(LAS s16x4*)(vd_ + 8) = __builtin_shufflevector(sv0, sv0, 4, 5, 6, 7); \
        *(LAS s16x4*)(vd_ + 64 * VPITCH) = __builtin_shufflevector(sv1, sv1, 0, 1, 2, 3); *(LAS s16x4*)(vd_ + 64 * VPITCH + 8) = __builtin_shufflevector(sv1, sv1, 4, 5, 6, 7); } while (0)
#define PVMM(vbuf_) do { const LAS unsigned char* vb_ = Vr + (vbuf_) * VBUFB + r32 * VPITCH + hi * 8; \
        _Pragma("unroll") for (int s = 0; s < 4; ++s) { \
            _Pragma("unroll") for (int d0 = 0; d0 < 4; ++d0) { const s16x4 vl_ = *(const LAS s16x4*)(vb_ + d0 * 32 * VPITCH + s * 32), vh_ = *(const LAS s16x4*)(vb_ + d0 * 32 * VPITCH + s * 32 + 16); \
                const bf16x8 a_ = (bf16x8){vl_[0], vl_[1], vl_[2], vl_[3], vh_[0], vh_[1], vh_[2], vh_[3]}; \
                o[d0] = __builtin_amdgcn_mfma_f32_32x32x16_bf16(a_, pb[s], o[d0], 0, 0, 0); } \
            __builtin_amdgcn_sched_barrier(0); } } while (0)
    LOADKV(jfirst); WRITEKV(0, 0);
    unsigned mb0 = 0xffffu, mb1 = 0xffffu;
    if (MODE == 0) { if (jfirst <= jact) { mb0 = mrow[(size_t)(2 * jfirst) * 64]; mb1 = mrow[(size_t)(2 * jfirst + 1) * 64]; } }
    bool wdone = false, pend = false;
    bf16x8 pb[4];
    int vcur = 0;
    __syncthreads();
    for (int it = 0; it < nt; ++it) {
        const int j = DESC ? j1 - 1 - it : j0 + it, jn = DESC ? j - 1 : j + 1;
        const int vprev = vcur == 0 ? 2 : vcur - 1, vnext = vcur == 2 ? 0 : vcur + 1;
        const bool more = it + 1 < nt;
        if (more) LOADKV(jn);
        unsigned nb0 = 0xffffu, nb1 = 0xffffu;
        if (MODE == 0) { if (more && jn <= jact && !wdone) { nb0 = mrow[(size_t)(2 * jn) * 64]; nb1 = mrow[(size_t)(2 * jn + 1) * 64]; } }
        if (pend) { PVMM(vprev); pend = false; }
        if (j <= jact && !wdone) {
            f32x16 s0, s1;
            const float base = (float)(64 * j - t + 4 * hi) * sl;
#pragma unroll
            for (int r = 0; r < 16; ++r) { const int c = (r & 3) + 8 * (r >> 2); s0[r] = fmaf(sl, (float)c, base); s1[r] = fmaf(sl, (float)(c + 32), base); }
            const LAS unsigned char* kb = Kr + (it & 1) * KBUFB + r32 * KPITCH + hi * 16;
#pragma unroll
            for (int g = 0; g < 2; ++g) {
                bf16x8 fa[4], fb[4];
#pragma unroll
                for (int d = 0; d < 4; ++d) { fa[d] = *(const LAS bf16x8*)(kb + (4 * g + d) * 32); fb[d] = *(const LAS bf16x8*)(kb + 32 * KPITCH + (4 * g + d) * 32); }
                __builtin_amdgcn_sched_barrier(0);
#pragma unroll
                for (int d = 0; d < 4; ++d) {
                    s0 = __builtin_amdgcn_mfma_f32_32x32x16_bf16(fa[d], qr[4 * g + d], s0, 0, 0, 0);
                    s1 = __builtin_amdgcn_mfma_f32_32x32x16_bf16(fb[d], qr[4 * g + d], s1, 0, 0, 0);
                }
                __builtin_amdgcn_sched_barrier(0);
            }
            if (MODE == 0) {
#pragma unroll
                for (int r = 0; r < 16; ++r) {
                    const unsigned u0 = (unsigned)__builtin_amdgcn_sbfe((int)mb0, r, 1), u1 = (unsigned)__builtin_amdgcn_sbfe((int)mb1, r, 1);
                    s0[r] = __uint_as_float((__float_as_uint(s0[r]) & u0) | (0xFF800000u & ~u0)); s1[r] = __uint_as_float((__float_as_uint(s1[r]) & u1) | (0xFF800000u & ~u1)); }
            }
            if (MODE == 2) {
                const int kp0 = 64 * j + 4 * hi;
#pragma unroll
                for (int r = 0; r < 16; ++r) { const int c = (r & 3) + 8 * (r >> 2); if (kp0 + c > t) s0[r] = NEG_INF; if (kp0 + c + 32 > t) s1[r] = NEG_INF; }
            }
            float tm = fmaxf(s0[0], s1[0]);
#pragma unroll
            for (int r = 1; r < 16; ++r) tm = fmaxf(tm, fmaxf(s0[r], s1[r]));
            tm = fmaxf(tm, __shfl_xor(tm, 32));
            const float mn = fmaxf(m, tm), alpha = fast_exp2((m - mn) * C2), mc = -mn * C2;
            m = mn;
            float ps = 0.f;
#pragma unroll
            for (int r = 0; r < 16; ++r) { s0[r] = fast_exp2(fmaf(s0[r], C2, mc)); s1[r] = fast_exp2(fmaf(s1[r], C2, mc)); ps += s0[r] + s1[r]; }
            ps += __shfl_xor(ps, 32);
            l = l * alpha + ps;
            if (__any(alpha != 1.0f)) {
#pragma unroll
                for (int d0 = 0; d0 < 4; ++d0)
#pragma unroll
                    for (int r = 0; r < 16; ++r) o[d0][r] *= alpha;
            }
            u32x4 pw;
            pw.x = cvt_pk_bf16(s0[0], s0[1]); pw.y = cvt_pk_bf16(s0[2], s0[3]); pw.z = cvt_pk_bf16(s0[4], s0[5]); pw.w = cvt_pk_bf16(s0[6], s0[7]); pb[0] = *(bf16x8*)&pw;
            pw.x = cvt_pk_bf16(s0[8], s0[9]); pw.y = cvt_pk_bf16(s0[10], s0[11]); pw.z = cvt_pk_bf16(s0[12], s0[13]); pw.w = cvt_pk_bf16(s0[14], s0[15]); pb[1] = *(bf16x8*)&pw;
            pw.x = cvt_pk_bf16(s1[0], s1[1]); pw.y = cvt_pk_bf16(s1[2], s1[3]); pw.z = cvt_pk_bf16(s1[4], s1[5]); pw.w = cvt_pk_bf16(s1[6], s1[7]); pb[2] = *(bf16x8*)&pw;
            pw.x = cvt_pk_bf16(s1[8], s1[9]); pw.y = cvt_pk_bf16(s1[10], s1[11]); pw.z = cvt_pk_bf16(s1[12], s1[13]); pw.w = cvt_pk_bf16(s1[14], s1[15]); pb[3] = *(bf16x8*)&pw;
            if (lag) pend = true; else PVMM(vcur);
            if (DESC) {
                const float xmax = rowb + sl * (float)(64 * j - 1 - t);
                wdone = __all(m > -1e29f && (xmax - m) * C2 < ATT_CUT) != 0;
            }
        }
        mb0 = nb0; mb1 = nb1;
        if (more) WRITEKV((it & 1) ^ 1, vnext);
        if (DESC) { if (lane == 0) donef[(it & 1) * 8 + wid] = wdone ? 1 : 0; }
        __syncthreads();
        vcur = vnext;
        if (DESC) { const LAS int* df = donef + (it & 1) * 8; if ((df[0] & df[1] & df[2] & df[3] & df[4] & df[5] & df[6] & df[7]) != 0) break; }
    }
    if (pend) { const int vprev = vcur == 0 ? 2 : vcur - 1; PVMM(vprev); }
    __syncthreads();
#undef LOADKV
#undef WRITEKV
#undef PVMM
    m_out = m; l_out = l;
}

constexpr int STG_OFF = ATT_SCR + 1024, STG_PITCH = 272, STG_WAVE = 32 * STG_PITCH, STG_END = STG_OFF + 8 * STG_WAVE;
static_assert(STG_END <= 158720, "lds");
#define STG_MEM() asm volatile("" ::: "memory")
__device__ __forceinline__ void stg_put_lines(LAS unsigned char* st, int lane, const u32x4 (&v)[8]) {
#pragma unroll
    for (int k = 0; k < 8; ++k) *(LAS u32x4*)(st + ((lane >> 3) + 8 * (k >> 1)) * STG_PITCH + 128 * (k & 1) + 16 * (lane & 7)) = v[k];
}
__device__ __forceinline__ void stg_get_lines(const LAS unsigned char* st, int lane, u32x4 (&v)[8]) {
#pragma unroll
    for (int k = 0; k < 8; ++k) v[k] = *(const LAS u32x4*)(st + ((lane >> 3) + 8 * (k >> 1)) * STG_PITCH + 128 * (k & 1) + 16 * (lane & 7));
}
__device__ __forceinline__ void stg_put_frag(LAS unsigned char* st, int r32, int hi, const u32x2 (&f)[16]) {
#pragma unroll
    for (int i = 0; i < 16; ++i) *(LAS u32x2*)(st + r32 * STG_PITCH + 64 * (i >> 2) + 16 * (i & 3) + 8 * hi) = f[i];
}
__device__ __forceinline__ void stg_get_frag(const LAS unsigned char* st, int r32, int hi, u32x2 (&f)[16]) {
#pragma unroll
    for (int i = 0; i < 16; ++i) f[i] = *(const LAS u32x2*)(st + r32 * STG_PITCH + 64 * (i >> 2) + 16 * (i & 3) + 8 * hi);
}
__device__ __forceinline__ void dsa_unit(LAS unsigned char* lds, int h, int qb, int j0, int j1, int slot, const bf16_t* Q, const bf16_t* K, const bf16_t* VT, const unsigned short* MASK, const bf16_t* SG, bf16_t* YG,
                                         bf16_t* PARTO, float* PARTML, float knb) {
    const int tid = opaque_tid(), wid = __builtin_amdgcn_readfirstlane(tid >> 6), lane = tid & 63, r32 = lane & 31, hi = lane >> 5;
    const int qt = 8 * qb + wid, t = 256 * qb + 32 * wid + r32;
    const float sl = exp2f(-(float)(h + 1)) / SCALE;
    f32x16 o[4]; float m, l;
    attn_core<0>(lds, K + (size_t)h * SEQ * HD, VT + (size_t)h * HD * SEQ, Q + ((size_t)h * SEQ + t) * HD, t, j0, j1, 4 * qb + (wid >> 1), sl,
                 MASK + ((size_t)qt * 512) * 64 + lane, knb, o, m, l);
    int te = t; asm volatile("" : "+v"(te));
    const float inv = l > 0.f ? 1.0f / l : 0.f;
    LAS unsigned char* st = lds + STG_OFF + wid * STG_WAVE;
    const int tw = 256 * qb + 32 * wid;
    if (slot < 0) {
        u32x4 ln[8];
#pragma unroll
        for (int k = 0; k < 8; ++k) ln[k] = *(const u32x4*)(SG + (size_t)(tw + (lane >> 3) + 8 * (k >> 1)) * DM + h * HD + 64 * (k & 1) + 8 * (lane & 7));
        stg_put_lines(st, lane, ln); STG_MEM();
        u32x2 f[16]; stg_get_frag(st, r32, hi, f); STG_MEM();
#pragma unroll
        for (int i = 0; i < 16; ++i) { const int d0 = i >> 2, r4 = i & 3; const u32x2 g = f[i];
            u32x2 w; w.x = cvt_pk_bf16(o[d0][4 * r4] * inv * bflo(g.x), o[d0][4 * r4 + 1] * inv * bfhi(g.x));
            w.y = cvt_pk_bf16(o[d0][4 * r4 + 2] * inv * bflo(g.y), o[d0][4 * r4 + 3] * inv * bfhi(g.y)); f[i] = w; }
        stg_put_frag(st, r32, hi, f); STG_MEM();
        stg_get_lines(st, lane, ln); STG_MEM();
#pragma unroll
        for (int k = 0; k < 8; ++k) *(u32x4*)(YG + (size_t)(tw + (lane >> 3) + 8 * (k >> 1)) * DM + h * HD + 64 * (k & 1) + 8 * (lane & 7)) = ln[k];
    } else {
        const size_t pw = (size_t)slot * 256 + 32 * wid;
        u32x2 f[16];
#pragma unroll
        for (int i = 0; i < 16; ++i) { const int d0 = i >> 2, r4 = i & 3;
            f[i].x = cvt_pk_bf16(o[d0][4 * r4] * inv, o[d0][4 * r4 + 1] * inv); f[i].y = cvt_pk_bf16(o[d0][4 * r4 + 2] * inv, o[d0][4 * r4 + 3] * inv); }
        stg_put_frag(st, r32, hi, f); STG_MEM();
        u32x4 ln[8]; stg_get_lines(st, lane, ln); STG_MEM();
#pragma unroll
        for (int k = 0; k < 8; ++k) *(u32x4*)(PARTO + (pw + (lane >> 3) + 8 * (k >> 1)) * HD + 64 * (k & 1) + 8 * (lane & 7)) = ln[k];
        if (hi == 0) *(f32x2*)(PARTML + (pw + r32) * 2) = (f32x2){m, l};
    }
}
__device__ __forceinline__ void dsa_merge(int bid, int G, int tid, const bf16_t* PARTO, const float* PARTML, const bf16_t* SG, bf16_t* YG) {
    for (int idx = bid * 512 + tid; idx < 48 * 256 * 16; idx += G * 512) {
        const int k = idx >> 12, row = (idx >> 4) & 255, dc = idx & 15;
        const int qb = 63 - k, t = 256 * qb + row, nch = (4 * qb + 4 + 63) >> 6;
        float pm[4], pl[4]; float M = -1e30f;
#pragma unroll
        for (int c = 0; c < 4; ++c) { pm[c] = -1e30f; pl[c] = 0.f; if (c < nch) { const f32x2 v = *(const f32x2*)(PARTML + ((size_t)(4 * k + c) * 256 + row) * 2); pm[c] = v[0]; pl[c] = v[1]; M = fmaxf(M, pm[c]); } }
        float acc[8] = {0.f, 0.f, 0.f, 0.f, 0.f, 0.f, 0.f, 0.f}; float den = 0.f;
#pragma unroll
        for (int c = 0; c < 4; ++c) if (c < nch && pl[c] > 0.f) {
            const float w = pl[c] * fast_exp2((pm[c] - M) * C2); den += w;
            const u32x4 x = *(const u32x4*)(PARTO + ((size_t)(4 * k + c) * 256 + row) * HD + dc * 8);
            acc[0] = fmaf(w, bflo(x.x), acc[0]); acc[1] = fmaf(w, bfhi(x.x), acc[1]); acc[2] = fmaf(w, bflo(x.y), acc[2]); acc[3] = fmaf(w, bfhi(x.y), acc[3]);
            acc[4] = fmaf(w, bflo(x.z), acc[4]); acc[5] = fmaf(w, bfhi(x.z), acc[5]); acc[6] = fmaf(w, bflo(x.w), acc[6]); acc[7] = fmaf(w, bfhi(x.w), acc[7]);
        }
        const float inv = 1.0f / den;
        const size_t off = (size_t)t * DM + 7 * HD + dc * 8;
        const u32x4 g = *(const u32x4*)(SG + off);
        u32x4 r;
        r.x = cvt_pk_bf16(acc[0] * inv * bflo(g.x), acc[1] * inv * bfhi(g.x)); r.y = cvt_pk_bf16(acc[2] * inv * bflo(g.y), acc[3] * inv * bfhi(g.y));
        r.z = cvt_pk_bf16(acc[4] * inv * bflo(g.z), acc[5] * inv * bfhi(g.z)); r.w = cvt_pk_bf16(acc[6] * inv * bflo(g.w), acc[7] * inv * bfhi(g.w));
        *(u32x4*)(YG + off) = r;
    }
}
__device__ __forceinline__ void moba_sel_unit(LAS unsigned char* lds, int h, int b, int c, int cnt, const unsigned* LIST, const bf16_t* Q, const bf16_t* K, const bf16_t* VT, bf16_t* PARTO, float* PARTML) {
    const int tid = opaque_tid(), wid = __builtin_amdgcn_readfirstlane(tid >> 6), lane = tid & 63, r32 = lane & 31, hi = lane >> 5;
    const int i = 256 * c + 32 * wid + r32; const bool valid = i < cnt;
    const unsigned e = LIST[((size_t)h * 64 + b) * SEQ + (valid ? i : cnt - 1)];
    const int t = (int)(e >> 2), rank = (int)(e & 3u);
    const float sl = exp2f(-(float)(h + 1)) / SCALE;
    f32x16 o[4]; float m, l;
    attn_core<1>(lds, K + (size_t)h * SEQ * HD, VT + (size_t)h * HD * SEQ, Q + ((size_t)h * SEQ + t) * HD, t, 4 * b, 4 * b + 4, (256 * c + 32 * wid < cnt) ? 4 * b + 3 : -1, sl, nullptr, 0.f, o, m, l);
    int te = t; asm volatile("" : "+v"(te));
    {
        const float inv = 1.0f / l; const unsigned pr = (unsigned)(((size_t)h * SEQ + te) * 3 + rank);
        LAS unsigned char* st = lds + STG_OFF + wid * STG_WAVE;
        u32x2 f[16];
#pragma unroll
        for (int i = 0; i < 16; ++i) { const int d0 = i >> 2, r4 = i & 3;
            f[i].x = cvt_pk_bf16(o[d0][4 * r4] * inv, o[d0][4 * r4 + 1] * inv); f[i].y = cvt_pk_bf16(o[d0][4 * r4 + 2] * inv, o[d0][4 * r4 + 3] * inv); }
        stg_put_frag(st, r32, hi, f);
        if (hi == 0) *(LAS unsigned*)(st + r32 * STG_PITCH + 256) = valid ? pr : 0xffffffffu;
        STG_MEM();
        u32x4 ln[8]; stg_get_lines(st, lane, ln);
        unsigned prow[4];
#pragma unroll
        for (int i = 0; i < 4; ++i) prow[i] = *(const LAS unsigned*)(st + ((lane >> 3) + 8 * i) * STG_PITCH + 256);
        STG_MEM();
#pragma unroll
        for (int k = 0; k < 8; ++k) if (prow[k >> 1] != 0xffffffffu) *(u32x4*)(PARTO + (size_t)prow[k >> 1] * HD + 64 * (k & 1) + 8 * (lane & 7)) = ln[k];
        if (valid && hi == 0) *(f32x2*)(PARTML + (size_t)pr * 2) = (f32x2){m, l};
    }
}
__device__ __forceinline__ void moba_own_unit(LAS unsigned char* lds, int h, int b, const bf16_t* Q, const bf16_t* K, const bf16_t* VT, const bf16_t* PARTO, const float* PARTML, const bf16_t* SG, bf16_t* YG) {
    const int tid = opaque_tid(), wid = __builtin_amdgcn_readfirstlane(tid >> 6), lane = tid & 63, r32 = lane & 31, hi = lane >> 5;
    const int t = 256 * b + 32 * wid + r32;
    const float sl = exp2f(-(float)(h + 1)) / SCALE;
    f32x16 o[4]; float m, l;
    attn_core<2>(lds, K + (size_t)h * SEQ * HD, VT + (size_t)h * HD * SEQ, Q + ((size_t)h * SEQ + t) * HD, t, 4 * b, 4 * b + 4, 4 * b + (wid >> 1), sl, nullptr, 0.f, o, m, l);
    int te = t; asm volatile("" : "+v"(te));
    const int nv = b < 3 ? b : 3; const size_t pr = ((size_t)h * SEQ + te) * 3;
    float pm[3], pl[3]; float M = m;
#pragma unroll
    for (int r = 0; r < 3; ++r) { pm[r] = -1e30f; pl[r] = 0.f; if (r < nv) { const f32x2 v = *(const f32x2*)(PARTML + (pr + r) * 2); pm[r] = v[0]; pl[r] = v[1]; M = fmaxf(M, pm[r]); } }
    const float wo = fast_exp2((m - M) * C2);
    float wr_[3]; float den = l * wo;
#pragma unroll
    for (int r = 0; r < 3; ++r) { wr_[r] = (r < nv) ? pl[r] * fast_exp2((pm[r] - M) * C2) : 0.f; den += wr_[r]; }
    const float inv = 1.0f / den;
    LAS unsigned char* st = lds + STG_OFF + wid * STG_WAVE;
    const int tw = 256 * b + 32 * wid;
    u32x4 lp[3][8], lg[8];
#pragma unroll
    for (int r = 0; r < 3; ++r) if (r < nv) {
#pragma unroll
        for (int k = 0; k < 8; ++k) lp[r][k] = *(const u32x4*)(PARTO + (((size_t)h * SEQ + tw + (lane >> 3) + 8 * (k >> 1)) * 3 + r) * HD + 64 * (k & 1) + 8 * (lane & 7));
    }
#pragma unroll
    for (int k = 0; k < 8; ++k) lg[k] = *(const u32x4*)(SG + (size_t)(tw + (lane >> 3) + 8 * (k >> 1)) * DM + HALFW + h * HD + 64 * (k & 1) + 8 * (lane & 7));
#pragma unroll
    for (int d0 = 0; d0 < 4; ++d0)
#pragma unroll
        for (int i = 0; i < 16; ++i) o[d0][i] *= wo;
    u32x2 f[16];
#pragma unroll
    for (int r = 0; r < 3; ++r) if (r < nv) {
        stg_put_lines(st, lane, lp[r]); STG_MEM();
        stg_get_frag(st, r32, hi, f); STG_MEM();
        const bool use = pl[r] > 0.f;
#pragma unroll
        for (int i = 0; i < 16; ++i) { const int d0 = i >> 2, r4 = i & 3; const u32x2 p = use ? f[i] : (u32x2){0u, 0u};
            o[d0][4 * r4] = fmaf(wr_[r], bflo(p.x), o[d0][4 * r4]); o[d0][4 * r4 + 1] = fmaf(wr_[r], bfhi(p.x), o[d0][4 * r4 + 1]);
            o[d0][4 * r4 + 2] = fmaf(wr_[r], bflo(p.y), o[d0][4 * r4 + 2]); o[d0][4 * r4 + 3] = fmaf(wr_[r], bfhi(p.y), o[d0][4 * r4 + 3]); }
    }
    stg_put_lines(st, lane, lg); STG_MEM();
    stg_get_frag(st, r32, hi, f); STG_MEM();
#pragma unroll
    for (int i = 0; i < 16; ++i) { const int d0 = i >> 2, r4 = i & 3; const u32x2 g = f[i];
        u32x2 w; w.x = cvt_pk_bf16(o[d0][4 * r4] * inv * bflo(g.x), o[d0][4 * r4 + 1] * inv * bfhi(g.x)); w.y = cvt_pk_bf16(o[d0][4 * r4 + 2] * inv * bflo(g.y), o[d0][4 * r4 + 3] * inv * bfhi(g.y)); f[i] = w; }
    stg_put_frag(st, r32, hi, f); STG_MEM();
    stg_get_lines(st, lane, lg); STG_MEM();
#pragma unroll
    for (int k = 0; k < 8; ++k) *(u32x4*)(YG + (size_t)(tw + (lane >> 3) + 8 * (k >> 1)) * DM + HALFW + h * HD + 64 * (k & 1) + 8 * (lane & 7)) = lg[k];
}
}

namespace dsa {
constexpr int NB = 512, CAP = 256;
constexpr int QPITCH = 1296;
constexpr int HSTR = 513;
__device__ __forceinline__ void fold_abs(f32x16& sc, const f32x16& a, float w) {
#pragma unroll
    for (int r = 0; r < 16; ++r) { float t = fmaf(w, __builtin_fabsf(a[r]), sc[r]); asm volatile("" : "+v"(t)); sc[r] = t; }
}
__device__ __forceinline__ void scores2(f32x16& sc0, f32x16& sc1, const bf16x8 (&ka)[4], const bf16x8 (&kb)[4], const LAS unsigned char* qrow, const float (&w)[8]) {
    bf16x8 b0[4], b1[4];
#define DSA_LDB(dst, off) do { _Pragma("unroll") for (int s_ = 0; s_ < 4; ++s_) dst[s_] = *(const LAS bf16x8*)(qrow + ((off) + 16 * s_) * 2); } while (0)
#define DSA_MM(c0, c1, bb) do { __builtin_amdgcn_s_setprio(1); _Pragma("unroll") for (int s_ = 0; s_ < 4; ++s_) { c0 = __builtin_amdgcn_mfma_f32_32x32x16_bf16(ka[s_], bb[s_], c0, 0, 0, 0); c1 = __builtin_amdgcn_mfma_f32_32x32x16_bf16(kb[s_], bb[s_], c1, 0, 0, 0); } __builtin_amdgcn_s_setprio(0); } while (0)
#define DSA_SB __builtin_amdgcn_sched_barrier(0)
    sc0 = f32x16{}; sc1 = f32x16{};
    DSA_LDB(b0, 512); DSA_LDB(b1, 0); DSA_SB;
    DSA_MM(sc0, sc1, b0); DSA_SB;
#define DSA_HEAD(h, cur, nxt) do { f32x16 a0 = {}, a1 = {}; if ((h) < 7) DSA_LDB(nxt, 64 * ((h) + 1)); DSA_SB; DSA_MM(a0, a1, cur); fold_abs(sc0, a0, w[h]); fold_abs(sc1, a1, w[h]); DSA_SB; } while (0)
    DSA_HEAD(0, b1, b0); DSA_HEAD(1, b0, b1); DSA_HEAD(2, b1, b0); DSA_HEAD(3, b0, b1); DSA_HEAD(4, b1, b0); DSA_HEAD(5, b0, b1); DSA_HEAD(6, b1, b0); DSA_HEAD(7, b0, b1);
#undef DSA_HEAD
#undef DSA_SB
#undef DSA_MM
#undef DSA_LDB
}
__device__ __forceinline__ void load_ka(bf16x8 (&ka)[4], const bf16_t* KI, int kt, int r32, int hi) {
    const bf16_t* kp = KI + (size_t)(32 * kt + r32) * 64 + 8 * hi;
#pragma unroll
    for (int s = 0; s < 4; ++s) ka[s] = *(const bf16x8*)(kp + 16 * s);
}
__device__ __forceinline__ int bin0f(float sc, int kofs) {
    const int b = __float_as_int(sc), kk = (b >> 19) & 0xFFF; int p = kk + kofs; p = p < 256 ? 256 : (p > NB - 1 ? NB - 1 : p); return p ^ ((b >> 31) & (NB - 1)); }
__device__ __forceinline__ int binf(float sc, float lo, float inv) { int b = (int)fmaf(sc, inv, -lo * inv); return b < 0 ? 0 : (b > NB - 1 ? NB - 1 : b); }
__device__ __forceinline__ void select_unit(LAS unsigned char* lds, int qt, const bf16_t* QI, const float* WI, const bf16_t* KI, float kib, unsigned short* MASK) {
    const int tid = opaque_tid(), wid = __builtin_amdgcn_readfirstlane(tid >> 6), lane = tid & 63, r32 = lane & 31, hi = lane >> 5;
    LAS unsigned* hist = (LAS unsigned*)lds;
    LAS float* cs = (LAS float*)lds; LAS unsigned short* ck = (LAS unsigned short*)(lds + 32768);
    LAS unsigned short* bits16 = (LAS unsigned short*)(lds + 49152); LAS unsigned* bits32 = (LAS unsigned*)(lds + 49152);
    LAS int* Tq = (LAS int*)(lds + 114688);
    LAS float* loq = (LAS float*)(Tq + 96);
    LAS float* invq = loq + 96;
    LAS int* abv = (LAS int*)(invq + 96);
    LAS int* needv = abv + 32; LAS int* donev = needv + 32; LAS int* Lq = donev + 32; LAS unsigned* ccnt = (LAS unsigned*)(Lq + 32); LAS int* KBq = (LAS int*)(ccnt + 32); LAS int* mode1 = KBq + 32; LAS int* flag = mode1 + 32;
    const int t = 32 * qt + r32;
    LAS unsigned char* qlds = lds + 117760;
    { const int row = tid >> 4, ch = tid & 15;
      bf16x8 qv[4];
#pragma unroll
      for (int i = 0; i < 4; ++i) qv[i] = *(const bf16x8*)(QI + (size_t)(32 * qt + row) * 512 + (ch * 4 + i) * 8);
      __builtin_amdgcn_sched_barrier(0);
#pragma unroll
      for (int i = 0; i < 4; ++i) *(LAS bf16x8*)(qlds + row * QPITCH + (ch * 4 + i) * 16) = qv[i]; }
    __syncthreads();
    const LAS unsigned char* qrow = qlds + r32 * QPITCH + hi * 16;
    float w[8];
    float bsum = 0.f;
    const f32x4 wia = *(const f32x4*)(WI + (size_t)t * 8), wib = *(const f32x4*)(WI + (size_t)t * 8 + 4);
#pragma unroll
    for (int h = 0; h < 8; ++h) {
        float ss = 0.f;
#pragma unroll
        for (int s = 0; s < 4; ++s) { const bf16x8 q8 = *(const LAS bf16x8*)(qrow + (64 * h + 16 * s) * 2);
#pragma unroll
            for (int e = 0; e < 8; ++e) { const float v = bf2f((unsigned short)q8[e]); ss = fmaf(v, v, ss); } }
        ss += __shfl_xor(ss, 32);
        w[h] = (h < 4 ? wia[h & 3] : wib[h & 3]) * 0.0625f;
        bsum += fabsf(w[h]) * sqrtf(ss);
    }
    bsum *= 2.0f;
    {
        const int q = tid >> 4, d0 = (tid & 15) * 4;
        float wq[8];
        { const f32x4 qa = *(const f32x4*)(WI + (size_t)(32 * qt + q) * 8), qb = *(const f32x4*)(WI + (size_t)(32 * qt + q) * 8 + 4);
#pragma unroll
          for (int h = 0; h < 8; ++h) wq[h] = (h < 4 ? qa[h & 3] : qb[h & 3]) * 0.0625f; }
        float c4[4] = {0.f, 0.f, 0.f, 0.f};
#pragma unroll
        for (int h = 0; h < 8; ++h) { const u32x2 v = *(const LAS u32x2*)(qlds + q * QPITCH + (64 * h + d0) * 2);
            c4[0] = fmaf(wq[h], bflo(v.x), c4[0]); c4[1] = fmaf(wq[h], bfhi(v.x), c4[1]); c4[2] = fmaf(wq[h], bflo(v.y), c4[2]); c4[3] = fmaf(wq[h], bfhi(v.y), c4[3]); }
        u32x2 hh, ll; hh.x = cvt_pk_bf16(c4[0], c4[1]); hh.y = cvt_pk_bf16(c4[2], c4[3]);
        ll.x = cvt_pk_bf16(c4[0] - bflo(hh.x), c4[1] - bfhi(hh.x)); ll.y = cvt_pk_bf16(c4[2] - bflo(hh.y), c4[3] - bfhi(hh.y));
        *(LAS u32x2*)(qlds + q * QPITCH + (512 + d0) * 2) = hh; *(LAS u32x2*)(qlds + q * QPITCH + (576 + d0) * 2) = ll;
    }
#ifndef BSCALE
#define BSCALE 1.0f
#endif
#ifdef KIBCONST
    kib = KIBCONST;
#endif
    { const float Bt = (bsum * kib * 1.02f + 1e-30f) * BSCALE;
      if (wid == 0 && hi == 0) { KBq[r32] = (__float_as_int(Bt) >> 19) + 1; mode1[r32] = 0; loq[r32] = 0.f; invq[r32] = 0.f; abv[r32] = 0; donev[r32] = 0; Lq[r32] = 0; Tq[r32] = -1; needv[r32] = 0; }
      if (tid < 3) flag[tid] = 0; }
    __syncthreads();
    for (int lvl = 0; lvl < 3; ++lvl) {
        for (int i = tid; i < 32 * HSTR; i += 512) hist[i] = 0u;
        __syncthreads();
        const float lo1 = loq[32 + r32], in1 = invq[32 + r32], lo2 = loq[64 + r32], in2 = invq[64 + r32];
        const int T0 = Tq[r32], T1 = Tq[32 + r32], mydone = donev[r32], kbq_ = KBq[r32], kofs = 512 - kbq_;
#ifndef REPA
#define REPA 0
#endif
        int dummy_ = 0;
        for (int repa = 0; repa <= REPA; ++repa) {
        const unsigned addv = repa == 0 ? 1u : 0u;
        bf16x8 ka[4], kb[4], kn[4], knb[4];
        if (2 * wid <= qt) { load_ka(ka, KI, 2 * wid, r32, hi); load_ka(kb, KI, 2 * wid + 1, r32, hi); }
        for (int kt = 2 * wid; kt <= qt; kt += 16) {
            asm volatile("" : "+v"(ka[0]), "+v"(ka[1]), "+v"(ka[2]), "+v"(ka[3]), "+v"(kb[0]), "+v"(kb[1]), "+v"(kb[2]), "+v"(kb[3]));
            if (kt + 16 <= qt) { load_ka(kn, KI, kt + 16, r32, hi); load_ka(knb, KI, kt + 17, r32, hi); }
            f32x16 sc0, sc1;
            scores2(sc0, sc1, ka, kb, qrow, w);
#pragma unroll
            for (int s = 0; s < 4; ++s) { ka[s] = kn[s]; kb[s] = knb[s]; }
            if (lvl == 0 && kt + 1 < qt) {
#ifdef PROBE_NOATOM
                if (repa > 0) {
#pragma unroll
                    for (int r = 0; r < 16; ++r) { dummy_ += bin0f(sc0[r], kofs) + bin0f(sc1[r], kofs); }
                } else
#endif
                {
#pragma unroll
                for (int r = 0; r < 16; ++r) { const int bin = bin0f(sc0[r], kofs); __hip_atomic_fetch_add(hist + r32 * HSTR + bin, addv, __ATOMIC_RELAXED, __HIP_MEMORY_SCOPE_WORKGROUP); }
#pragma unroll
                for (int r = 0; r < 16; ++r) { const int bin = bin0f(sc1[r], kofs); __hip_atomic_fetch_add(hist + r32 * HSTR + bin, addv, __ATOMIC_RELAXED, __HIP_MEMORY_SCOPE_WORKGROUP); }
                }
            } else {
#pragma unroll
                for (int half = 0; half < 2; ++half)
#pragma unroll
                for (int r = 0; r < 16; ++r) {
                    const float v = half ? sc1[r] : sc0[r];
                    const int kp = 32 * (kt + half) + crow(r, hi);
                    bool mem = (kp <= t) && (mydone == 0);
                    const int b0 = bin0f(v, kofs), b1 = binf(v, lo1, in1);
                    if (lvl > 0) mem = mem && (b0 == T0);
                    if (lvl > 1) mem = mem && (b1 == T1);
                    if (mem) { const int bin = lvl == 0 ? b0 : (lvl == 1 ? b1 : binf(v, lo2, in2)); __hip_atomic_fetch_add(hist + r32 * HSTR + bin, addv, __ATOMIC_RELAXED, __HIP_MEMORY_SCOPE_WORKGROUP); }
                }
            }
        }
        }
        if (dummy_ == 0x7fffffff) hist[0] = 1u;
        __syncthreads();
        for (int qq = 0; qq < 4; ++qq) {
            const int q = 4 * wid + qq;
            if (donev[q] != 0) continue;
            const unsigned target = (unsigned)(256 - abv[q]);
            unsigned c[8]; unsigned tot = 0;
#pragma unroll
            for (int i = 0; i < 8; ++i) { c[i] = hist[q * HSTR + 8 * lane + i]; tot += c[i]; }
            unsigned suf = tot;
#pragma unroll
            for (int off = 1; off < 64; off <<= 1) { const unsigned v = __shfl_down(suf, off); if (lane + off < 64) suf += v; }
            const unsigned long long bal = __ballot(suf >= target);
            if (bal == 0ull) { if (lane == 0) { Tq[lvl * 32 + q] = -1; needv[q] = 0; donev[q] = 1; Lq[q] = lvl; } }
            else {
                const int Lc = 63 - __builtin_clzll(bal);
                if (lane == Lc) {
                    unsigned above = suf - tot; int T = 8 * lane; int nd = 0; unsigned cand = 0;
#pragma unroll
                    for (int b = 7; b >= 0; --b) { if (nd == 0) { if (above + c[b] >= target) { T = 8 * lane + b; nd = (int)(target - above); cand = c[b]; } else above += c[b]; } }
                    Tq[lvl * 32 + q] = T; needv[q] = nd; abv[q] = 256 - nd;
#ifdef PROBE_NOREFINE
                    if (cand > (unsigned)CAP) { Tq[lvl * 32 + q] = T - 1; needv[q] = 0; }
                    if (true) { donev[q] = 1; Lq[q] = lvl; }
#else
                    if (cand <= (unsigned)CAP || lvl == 2) { donev[q] = 1; Lq[q] = lvl; }
#endif
                    else { const int kbq = KBq[q];
                           if (lvl == 0) { float e0, e1; const int kbp = kbq - 256;
                               if (T >= 256) { const int kk = T - 256 + kbp; e0 = (T == 256) ? 0.f : __int_as_float(kk << 19); e1 = __int_as_float((kk + 1) << 19); }
                               else { const int kk = 255 - T + kbp; e0 = -__int_as_float((kk + 1) << 19); e1 = (T == 255) ? 0.f : -__int_as_float(kk << 19); }
                               loq[32 + q] = e0; invq[32 + q] = (float)NB / (e1 - e0);
                           } else { const float lo = loq[32 + q], in = invq[32 + q]; loq[64 + q] = lo + (float)T / in; invq[64 + q] = in * (float)NB; }
                           flag[lvl] = 1; }
                }
            }
        }
        __syncthreads();
        if (flag[lvl] == 0) break;
    }
    if (tid < 32) ccnt[tid] = 0u;
    __syncthreads();
    {
        const float lo1 = loq[32 + r32], in1 = invq[32 + r32], lo2 = loq[64 + r32], in2 = invq[64 + r32];
        const int T0 = Tq[r32], T1 = Tq[32 + r32], T2 = Tq[64 + r32], L = Lq[r32], kbq_ = KBq[r32], kofs = 512 - kbq_;
        const bool fast = (flag[0] == 0);
        float thA, thB; bool centre = (T0 == 255 || T0 == 256);
        if (T0 < 0) { thA = NEG_INF; thB = NEG_INF; }
        else if (T0 >= 257) { thA = (T0 == 511) ? __builtin_inff() : __int_as_float((T0 + 1 - kofs) << 19); thB = __int_as_float((T0 - kofs) << 19); }
        else { const unsigned M1 = (unsigned)(511 - T0 - kofs) << 19;
               thA = __uint_as_float((0x80000000u | M1) - 1u); thB = (T0 == 0) ? __uint_as_float(0xFF7FFFFFu) : __uint_as_float((0x80000000u | (M1 + (1u << 19))) - 1u); }
        { const int kkE = T0 >= 257 ? T0 - kofs : 511 - T0 - kofs; if (T0 >= 0 && (kkE < 1 || kkE > 4078)) centre = true; }
        const bool fast2 = fast && !__any(centre);
        bf16x8 ka[4], kb[4], kn[4], knb[4];
        if (2 * wid <= qt) { load_ka(ka, KI, 2 * wid, r32, hi); load_ka(kb, KI, 2 * wid + 1, r32, hi); }
        for (int kt = 2 * wid; kt <= qt; kt += 16) {
            asm volatile("" : "+v"(ka[0]), "+v"(ka[1]), "+v"(ka[2]), "+v"(ka[3]), "+v"(kb[0]), "+v"(kb[1]), "+v"(kb[2]), "+v"(kb[3]));
            if (kt + 16 <= qt) { load_ka(kn, KI, kt + 16, r32, hi); load_ka(knb, KI, kt + 17, r32, hi); }
            f32x16 sc0, sc1;
            scores2(sc0, sc1, ka, kb, qrow, w);
#pragma unroll
            for (int s = 0; s < 4; ++s) { ka[s] = kn[s]; kb[s] = knb[s]; }
            unsigned bits0 = 0u, bits1 = 0u;
            if (fast2 && kt + 1 < qt) {
#pragma unroll
                for (int half = 0; half < 2; ++half) {
                    unsigned bv = 0u;
#pragma unroll
                    for (int r = 15; r >= 0; --r) {
                        const float v = half ? sc1[r] : sc0[r];
                        asm volatile("v_cmp_ge_f32_e32 vcc, %1, %2\n\ts_nop 1\n\tv_addc_co_u32_e32 %0, vcc, %0, %0, vcc" : "+v"(bv) : "v"(v), "v"(thA) : "vcc");
                        if (v >= thB && v < thA) { const unsigned s = __hip_atomic_fetch_add(ccnt + r32, 1u, __ATOMIC_RELAXED, __HIP_MEMORY_SCOPE_WORKGROUP); if (s < (unsigned)CAP) { cs[r32 * CAP + s] = v; ck[r32 * CAP + s] = (unsigned short)(32 * (kt + half) + crow(r, hi)); } }
                    }
                    if (half) bits1 = bv; else bits0 = bv;
                }
            } else if (fast && kt + 1 < qt) {
#pragma unroll
                for (int half = 0; half < 2; ++half)
#pragma unroll
                for (int r = 0; r < 16; ++r) {
                    const float v = half ? sc1[r] : sc0[r];
                    const int b0 = bin0f(v, kofs);
                    if (half) bits1 |= (b0 > T0) ? (1u << r) : 0u; else bits0 |= (b0 > T0) ? (1u << r) : 0u;
                    if (b0 == T0) { const unsigned s = __hip_atomic_fetch_add(ccnt + r32, 1u, __ATOMIC_RELAXED, __HIP_MEMORY_SCOPE_WORKGROUP); if (s < (unsigned)CAP) { cs[r32 * CAP + s] = v; ck[r32 * CAP + s] = (unsigned short)(32 * (kt + half) + crow(r, hi)); } }
                }
            } else {
#pragma unroll
                for (int half = 0; half < 2; ++half)
#pragma unroll
                for (int r = 0; r < 16; ++r) {
                    const float v = half ? sc1[r] : sc0[r];
                    const int kp = 32 * (kt + half) + crow(r, hi);
                    if (kp <= t) {
                        const int b0 = bin0f(v, kofs);
                        bool sel = b0 > T0, cand = (b0 == T0);
                        if (cand && L > 0) { const int b1 = binf(v, lo1, in1); sel = b1 > T1; cand = (b1 == T1);
                            if (cand && L > 1) { const int b2 = binf(v, lo2, in2); sel = b2 > T2; cand = (b2 == T2); } }
                        if (sel) { if (half) bits1 |= 1u << r; else bits0 |= 1u << r; }
                        else if (cand) { const unsigned s = __hip_atomic_fetch_add(ccnt + r32, 1u, __ATOMIC_RELAXED, __HIP_MEMORY_SCOPE_WORKGROUP); if (s < (unsigned)CAP) { cs[r32 * CAP + s] = v; ck[r32 * CAP + s] = (unsigned short)kp; } }
                    }
                }
            }
            bits16[kt * 64 + lane] = (unsigned short)bits0;
            bits16[(kt + 1) * 64 + lane] = (unsigned short)bits1;
        }
    }
    __syncthreads();
#ifdef DBG_OVF
    if (tid < 32 && ccnt[tid] > (unsigned)CAP) atomicAdd((unsigned*)((unsigned char*)MASK - WS_MASK) + 3, 1u);
#endif
#ifndef REPR
#define REPR 0
#endif
    for (int repr = 0; repr <= REPR; ++repr)
    for (int qq = 0; qq < 4; ++qq) {
        const int q = 4 * wid + qq; const int nd = needv[q]; unsigned n = ccnt[q]; n = n > (unsigned)CAP ? (unsigned)CAP : n;
        if (nd <= 0 || n == 0u) continue;
        unsigned key[4], kk[4]; bool val[4];
#pragma unroll
        for (int e = 0; e < 4; ++e) { const unsigned i = lane + 64 * e; val[e] = i < n; const unsigned u = val[e] ? __float_as_uint(cs[q * CAP + i]) : 0u; key[e] = (u & 0x80000000u) ? ~u : (u | 0x80000000u); kk[e] = val[e] ? (unsigned)ck[q * CAP + i] : 0xffffffffu; if (!val[e]) key[e] = 0u; }
        unsigned x = 0u;
        for (int bit = 31; bit >= 0; --bit) {
            const unsigned trial = x | (1u << bit); int c = 0;
#pragma unroll
            for (int e = 0; e < 4; ++e) c += __popcll(__ballot(val[e] && key[e] >= trial));
            if (c >= nd) x = trial;
        }
        int cgt = 0;
#pragma unroll
        for (int e = 0; e < 4; ++e) cgt += __popcll(__ballot(val[e] && key[e] > x));
        int ties = nd - cgt;
        bool sel[4];
#pragma unroll
        for (int e = 0; e < 4; ++e) sel[e] = val[e] && key[e] > x;
        unsigned last = 0u; bool first = true;
        for (int it = 0; it < ties; ++it) {
            unsigned best = 0xffffffffu;
#pragma unroll
            for (int e = 0; e < 4; ++e) { const bool ok = val[e] && key[e] == x && (first || kk[e] > last); best = ok && kk[e] < best ? kk[e] : best; }
#pragma unroll
            for (int o = 1; o < 64; o <<= 1) { const unsigned v = __shfl_xor(best, o); best = v < best ? v : best; }
            if (best == 0xffffffffu) break;
#pragma unroll
            for (int e = 0; e < 4; ++e) sel[e] = sel[e] || (val[e] && key[e] == x && kk[e] == best);
            last = best; first = false;
        }
#pragma unroll
        for (int e = 0; e < 4; ++e) if (sel[e]) {
            const unsigned ki = kk[e];
            const int kt = (int)(ki >> 5), cc = (int)(ki & 31u), hh = (cc >> 2) & 1, rr = (cc & 3) + 4 * (cc >> 3);
            const int idx = kt * 64 + hh * 32 + q;
            __hip_atomic_fetch_or(bits32 + (idx >> 1), 1u << (16 * (idx & 1) + rr), __ATOMIC_RELAXED, __HIP_MEMORY_SCOPE_WORKGROUP);
        }
    }
    __syncthreads();
    { const int nw = (qt + 1 + ((qt & 1) == 0 ? 1 : 0)) * 32; unsigned* mw = (unsigned*)MASK + (size_t)qt * 512 * 32;
      for (int i = tid; i < nw; i += 512) mw[i] = bits32[i]; }
    __syncthreads();
}
}

__device__ __forceinline__ void conv_unit(LAS unsigned char* lds, int tile, const bf16_t* U, const float* cw, const float* cb, const float* lg, const float* lb, const bf16_t* SG, bf16_t* YG) {
    const int tid = opaque_tid(), wid = __builtin_amdgcn_readfirstlane(tid >> 6), lane = tid & 63;
    const int t0 = 32 * tile, c0 = 2 * tid;
    float w0[31], w1[31];
#pragma unroll
    for (int j = 0; j < 31; ++j) { const f32x2 v = *(const f32x2*)(cw + j * HALFW + c0); w0[j] = v[0]; w1[j] = v[1]; }
    float y0[32], y1[32];
    { const f32x2 b = *(const f32x2*)(cb + c0);
#pragma unroll
      for (int i = 0; i < 32; ++i) { y0[i] = b[0]; y1[i] = b[1]; } }
#define CONV_LD(dst, base_i) do { _Pragma("unroll") for (int i_ = 0; i_ < 16; ++i_) { const int ti = t0 - 30 + (base_i) + i_; const unsigned v_ = *(const unsigned*)(U + (size_t)(ti < 0 ? 0 : (ti > SEQ - 1 ? SEQ - 1 : ti)) * HALFW + c0); dst[i_] = (ti < 0 || (base_i) + i_ >= 62) ? 0u : v_; } } while (0)
#define CONV_AP(src, base_i) do { _Pragma("unroll") for (int i_ = 0; i_ < 16; ++i_) { const float u0 = bflo(src[i_]), u1 = bfhi(src[i_]); \
        _Pragma("unroll") for (int j = 0; j < 31; ++j) { const int tt = (base_i) + i_ - j; if ((base_i) + i_ < 62 && tt >= 0 && tt < 32) { y0[tt] = fmaf(w0[j], u0, y0[tt]); y1[tt] = fmaf(w1[j], u1, y1[tt]); } } } } while (0)
    { unsigned ua[16], ub[16];
      CONV_LD(ua, 0); CONV_LD(ub, 16); CONV_AP(ua, 0); CONV_LD(ua, 32); CONV_AP(ub, 16); CONV_LD(ub, 48); CONV_AP(ua, 32); CONV_AP(ub, 48); }
#undef CONV_LD
#undef CONV_AP
    float v[64];
#pragma unroll
    for (int i = 0; i < 32; ++i) { v[i] = y0[i] + y1[i]; v[32 + i] = y0[i] * y0[i] + y1[i] * y1[i]; }
#pragma unroll
    for (int k = 32; k >= 1; k >>= 1) {
        const bool up = (lane & k) != 0;
#pragma unroll
        for (int i = 0; i < k; ++i) { const float keep = up ? v[k + i] : v[i], give = up ? v[i] : v[k + i]; v[i] = keep + __shfl_xor(give, k); }
    }
    LAS float* part = (LAS float*)(lds + SCR_OFF);
    LAS float* stat = part + 512;
    __syncthreads();
    part[wid * 64 + lane] = v[0];
    __syncthreads();
    if (tid < 64) { float s = 0.f;
#pragma unroll
        for (int w8 = 0; w8 < 8; ++w8) s += part[w8 * 64 + tid];
        part[tid] = s; }
    __syncthreads();
    if (tid < 32) { const float mean = part[tid] * (1.0f / 1024.0f); const float var = part[32 + tid] * (1.0f / 1024.0f) - mean * mean; stat[tid] = mean; stat[32 + tid] = __builtin_amdgcn_rsqf(fmaxf(var, 0.f) + EPS); }
    __syncthreads();
    const f32x2 g = *(const f32x2*)(lg + c0), bb = *(const f32x2*)(lb + c0);
    unsigned sgv[32];
#pragma unroll
    for (int i = 0; i < 32; ++i) sgv[i] = *(const unsigned*)(SG + (size_t)(t0 + i) * DM + HALFW + c0);
    __builtin_amdgcn_sched_barrier(0);
#pragma unroll
    for (int i = 0; i < 32; ++i) {
        const float mean = stat[i], rstd = stat[32 + i];
        const float a0 = siluf_((y0[i] - mean) * rstd * g[0] + bb[0]), a1 = siluf_((y1[i] - mean) * rstd * g[1] + bb[1]);
        const size_t off = (size_t)(t0 + i) * DM + HALFW + c0;
        const unsigned sg = sgv[i];
        *(unsigned*)(YG + off) = cvt_pk_bf16(a0 * bflo(sg), a1 * bfhi(sg));
    }
}

constexpr int N_PHASES = 26;
struct Args { const float* in[18]; float* out; unsigned char* ws; int ph_lo, ph_hi; };
template <int MASK>
__global__ void __launch_bounds__(512, 2) trunk_fwd(Args a_unused) {
    extern __shared__ __attribute__((aligned(16))) unsigned char lds_raw[];
#define SITE_BEGIN() \
    const __attribute__((address_space(4))) Args* ap = (const __attribute__((address_space(4))) Args*)__builtin_amdgcn_kernarg_segment_ptr(); asm volatile("" : "+s"(ap)); \
    Frame F; { F.tid = opaque_tid(); F.lane = F.tid & 63; F.wave = __builtin_amdgcn_readfirstlane(F.tid >> 6); int b_ = blockIdx.x, g_ = gridDim.x; asm volatile("" : "+s"(b_), "+s"(g_)); F.bid = b_; F.G = g_; } \
    F.lds = (LAS unsigned char*)lds_raw; unsigned char* ws = ap->ws; F.ctl = (unsigned*)(ws + WS_CTL); (void)ws
#define EN(k) (((MASK) >> (k)) & 1)
#define RUN(p) (lo <= (p) && (p) < hi)
#ifdef REPBAR
#define SEAM(p) do { if ((p) + 1 < hi) { xcd_barrier(bar); xcd_barrier(bar); xcd_barrier(bar); } } while (0)
#else
#define SEAM(p) do { if ((p) + 1 < hi) xcd_barrier(bar); } while (0)
#endif
    int lo, hi; XcdBarrier bar;
    {
        const __attribute__((address_space(4))) Args* ap0 = (const __attribute__((address_space(4))) Args*)__builtin_amdgcn_kernarg_segment_ptr();
        lo = ap0->ph_lo; hi = ap0->ph_hi;
        volatile LAS unsigned* MISC = (volatile LAS unsigned*)((LAS unsigned char*)lds_raw + MISC_OFF);
        if (threadIdx.x < 64) MISC[threadIdx.x] = 0u;
        __syncthreads();
        unsigned* barw = (unsigned*)(ap0->ws + WS_CTL) + CW_BAR;
        bar.bar = barw; bar.x = 0; bar.st = nullptr;
        if (hi - lo > 1) bar = xcd_barrier_post(barw, MISC + 8);
    }
    if (EN(0) && RUN(0)) { SITE_BEGIN();
#ifdef REP0
        for (int rep_ = 0; rep_ < 2; ++rep_)
#endif
        phase_p0a(F, ap->in[1], ap->in[3], ap->in[5], ap->in[6], ap->in[7], ap->in[11], ws); SEAM(0); }
    if (EN(1) && RUN(1)) { SITE_BEGIN(); phase_p0b(F, ap->in[4], ws); SEAM(1); }
    for (int lp = 0; lp < 2; ++lp) {
        const int pb = 2 + 12 * lp;
        if (EN(2) && RUN(pb + 0)) { SITE_BEGIN(); const int l = 2 * lp;
            if (l == 0) phase_norm<false>(F, ap->in[0], ap->in[2] + l * DM, (const float*)(ws + WS_MODF) + l * 6144, (bf16_t*)(ws + WS_H));
            else phase_norm<true>(F, ws + WS_XB, ap->in[2] + l * DM, (const float*)(ws + WS_MODF) + l * 6144, (bf16_t*)(ws + WS_H));
            SEAM(pb + 0); }
        if (EN(3) && RUN(pb + 1)) { SITE_BEGIN(); const int e = lp;
#ifdef REP3
            for (int rep_ = 0; rep_ < 2; ++rep_) {
#endif
            const bf16_t* WEV = (const bf16_t*)(ws + WS_WEV) + (size_t)e * EV_N * DM; const bf16_t* H = (const bf16_t*)(ws + WS_H);
            { pg8::Gemm g{H, WEV, SEQ, EV_MAIN, DM}; pg8::StaticOrder S; S.init(SEQ, EV_MAIN, F.G, F.bid);
              epi::EpiEven E{ws, (float*)(ws + WS_CTL + CTL_KMEAN_OFF) + (size_t)e * 65536, ap->in[9] + e * HD, ap->in[10] + e * HD, F.lds + SCR_OFF};
              pg8::gemm_phase(F.lds, g, S, E); }
#ifndef NO_VT
            { pg8::Gemm g{WEV + (size_t)EV_MAIN * DM, H, HALFW, SEQ, DM}; pg8::StaticOrder S; S.init(HALFW, SEQ, F.G, F.bid);
              epi::EpiVT E{(bf16_t*)(ws + WS_VT)}; pg8::gemm_phase(F.lds, g, S, E); }
#endif
#ifdef REP3
            }
#endif
            SEAM(pb + 1); }
        if (EN(4) && RUN(pb + 2)) { SITE_BEGIN(); const int e = lp;
#ifdef REPD
            for (int rep_ = 0; rep_ < 2; ++rep_)
#endif
            phase_pool_d(F, (const bf16_t*)(ws + WS_UA), (bf16_t*)(ws + WS_D));
            float knb; { const float* kn = ap->in[10] + e * HD; float mx = fmaxf(fabsf(kn[F.lane]), fabsf(kn[64 + F.lane]));
#pragma unroll
              for (int o_ = 1; o_ < 64; o_ <<= 1) mx = fmaxf(mx, __shfl_xor(mx, o_));
              knb = mx * 11.3137085f * 1.01f; }
            phase_top3(F, (const bf16_t*)(ws + WS_Q), (const float*)(ws + WS_CTL + CTL_KMEAN_OFF) + (size_t)e * 65536, F.ctl + CW_CNT + e * 512 * 16, (unsigned*)(ws + WS_LIST), (float*)(ws + WS_PARTML), knb); SEAM(pb + 2); }
        if (EN(5) && RUN(pb + 3)) { SITE_BEGIN(); const int e = lp;
#ifdef REP5
            for (int rep_ = 0; rep_ < 2; ++rep_) {
#endif
            { pg8::Gemm g{(const bf16_t*)(ws + WS_D), (const bf16_t*)(ws + WS_PWT) + (size_t)e * 4 * 65536, 4 * SEQ, HALFW, 256}; pg8::PoolOrder S{F.G, F.bid};
              epi::EpiPool E{ap->in[8] + e * HALFW, (const bf16_t*)(ws + WS_SG), (bf16_t*)(ws + WS_H)}; pg8::gemm_phase(F.lds, g, S, E); }
            LAS int* offt = (LAS int*)(F.lds + 158720);
            const unsigned* cnt = F.ctl + CW_CNT + e * 512 * 16;
            __syncthreads();
            if (F.wave == 0) {
                int loc[8]; int s = 0;
#pragma unroll
                for (int i = 0; i < 8; ++i) { const int idx = F.lane * 8 + i; const int c = (int)__hip_atomic_load(cnt + idx * 16, __ATOMIC_RELAXED, __HIP_MEMORY_SCOPE_AGENT); loc[i] = ((idx & 63) < 63) ? ((c + 255) >> 8) : 0; s += loc[i]; }
                int inc = s;
#pragma unroll
                for (int off = 1; off < 64; off <<= 1) { const int v = __shfl_up(inc, off); if (F.lane >= off) inc += v; }
                int ex = inc - s;
#pragma unroll
                for (int i = 0; i < 8; ++i) { offt[F.lane * 8 + i] = ex; ex += loc[i]; }
                if (F.lane == 63) offt[512] = inc;
            }
            __syncthreads();
            const int total = offt[512];
            for (int u = F.bid; u < total; u += F.G) {
                int lo_ = 0, hi_ = 511;
                while (lo_ < hi_) { const int mid = (lo_ + hi_ + 1) >> 1; if (offt[mid] <= u) lo_ = mid; else hi_ = mid - 1; }
                const int idx = lo_, c = u - offt[idx];
                att::moba_sel_unit(F.lds, idx >> 6, idx & 63, c, (int)__hip_atomic_load(cnt + idx * 16, __ATOMIC_RELAXED, __HIP_MEMORY_SCOPE_AGENT), (const unsigned*)(ws + WS_LIST), (const bf16_t*)(ws + WS_Q), (const bf16_t*)(ws + WS_K), (const bf16_t*)(ws + WS_VT),
                                   (bf16_t*)(ws + WS_PARTO), (float*)(ws + WS_PARTML));
            }
#ifdef REP5
            }
#endif
            SEAM(pb + 3); }
        if (EN(6) && RUN(pb + 4)) { SITE_BEGIN();
#ifdef REP6
            for (int rep_ = 0; rep_ < 2; ++rep_)
#endif
            for (int u = F.bid; u < 512; u += F.G) att::moba_own_unit(F.lds, u & 7, u >> 3, (const bf16_t*)(ws + WS_Q), (const bf16_t*)(ws + WS_K), (const bf16_t*)(ws + WS_VT),
                                                                     (const bf16_t*)(ws + WS_PARTO), (const float*)(ws + WS_PARTML), (const bf16_t*)(ws + WS_SG), (bf16_t*)(ws + WS_H));
            SEAM(pb + 4); }
        if (EN(7) && RUN(pb + 5)) { SITE_BEGIN(); const int l = 2 * lp;
            pg8::Gemm g{(const bf16_t*)(ws + WS_H), (const bf16_t*)(ws + WS_WOUT) + (size_t)l * DM * DM, SEQ, DM, DM}; pg8::StaticOrder S; S.init(SEQ, DM, F.G, F.bid);
            if (l == 0) { epi::EpiOut<false, true> E{ap->in[0], ws + WS_XB, (const float*)(ws + WS_MODF) + l * 6144 + 2 * DM, F.lds + SCR_OFF}; pg8::gemm_phase(F.lds, g, S, E); }
            else { epi::EpiOut<true, true> E{ws + WS_XB, ws + WS_XB, (const float*)(ws + WS_MODF) + l * 6144 + 2 * DM, F.lds + SCR_OFF}; pg8::gemm_phase(F.lds, g, S, E); }
            SEAM(pb + 5); }
        if (EN(8) && RUN(pb + 6)) { SITE_BEGIN(); const int l = 2 * lp + 1;
#ifdef REPN
            for (int rep_ = 0; rep_ < 2; ++rep_)
#endif
            phase_norm<true>(F, ws + WS_XB, ap->in[2] + l * DM, (const float*)(ws + WS_MODF) + l * 6144, (bf16_t*)(ws + WS_H)); SEAM(pb + 6); }
        if (EN(9) && RUN(pb + 7)) { SITE_BEGIN(); const int o = lp;
#ifdef REP9
            for (int rep_ = 0; rep_ < 2; ++rep_) {
#endif
            const bf16_t* WOD = (const bf16_t*)(ws + WS_WOD) + (size_t)o * OD_N * DM; const bf16_t* H = (const bf16_t*)(ws + WS_H);
            { pg8::Gemm g{H, WOD, SEQ, OD_MAIN, DM}; pg8::StaticOrder S; S.init(SEQ, OD_MAIN, F.G, F.bid);
              epi::EpiOdd E{ws, F.ctl + CW_KIMAX + o * 8, ap->in[12] + o * HD, ap->in[13] + o * HD, F.lds + SCR_OFF};
              pg8::gemm_phase(F.lds, g, S, E); }
            { pg8::Gemm g{WOD + (size_t)OD_MAIN * DM, H, HALFW, SEQ, DM}; pg8::StaticOrder S; S.init(HALFW, SEQ, F.G, F.bid);
              epi::EpiVT E{(bf16_t*)(ws + WS_VT)}; pg8::gemm_phase(F.lds, g, S, E); }
#ifdef REP9
            }
#endif
            SEAM(pb + 7); }
        if (EN(10) && RUN(pb + 8)) {
            { SITE_BEGIN(); const int o = lp;
#ifdef REPC
              for (int rep_ = 0; rep_ < 2; ++rep_)
#endif
              for (int tile = F.bid; tile < 512; tile += F.G)
                  conv_unit(F.lds, tile, (const bf16_t*)(ws + WS_U), ap->in[14] + (size_t)o * 31 * HALFW, ap->in[15] + o * HALFW, ap->in[16] + o * HALFW, ap->in[17] + o * HALFW, (const bf16_t*)(ws + WS_SG), (bf16_t*)(ws + WS_H)); }
            { SITE_BEGIN(); const int o = lp;
              const unsigned* kimax = F.ctl + CW_KIMAX + o * 8;
              float kb2 = 0.f;
#pragma unroll
              for (int i = 0; i < 8; ++i) kb2 += __uint_as_float(__hip_atomic_load(kimax + i, __ATOMIC_RELAXED, __HIP_MEMORY_SCOPE_AGENT));
              const float kib = sqrtf(kb2);
              __syncthreads();
#ifdef REP10
              for (int rep_ = 0; rep_ < 2; ++rep_)
#endif
              for (int p = F.bid; p < 512; p += F.G) { const int qt = p < 256 ? p : 767 - p;
                  dsa::select_unit(F.lds, qt, (const bf16_t*)(ws + WS_QI), (const float*)(ws + WS_WI), (const bf16_t*)(ws + WS_KI), kib, (unsigned short*)(ws + WS_MASK)); } }
            SEAM(pb + 8); }
        if (EN(11) && RUN(pb + 9)) { SITE_BEGIN();
            float knb; { const float* kn = ap->in[13] + lp * HD; float mx = fmaxf(fabsf(kn[F.lane]), fabsf(kn[64 + F.lane]));
#pragma unroll
              for (int o_ = 1; o_ < 64; o_ <<= 1) mx = fmaxf(mx, __shfl_xor(mx, o_));
              knb = mx * 11.3137085f * 1.01f; }
            LAS int* uq = (LAS int*)(F.lds + att::ATT_SCR + 256);
            for (;;) {
                __syncthreads();
                if (F.tid == 0) uq[0] = (int)atomicAdd(F.ctl + CW_DQ + lp, 1u);
                __syncthreads();
                const int u = uq[0]; if (u >= 608) break;
                int h, qb, j0, j1, slot = -1;
                if (u < 64) { h = 6; qb = 63 - u; j0 = 0; j1 = 4 * qb + 4; }
                else if (u < 208) { int v = u - 64, k, c;
                    if (v < 64) { k = v >> 2; c = v & 3; } else if (v < 112) { v -= 64; k = 16 + v / 3; c = v % 3; } else { v -= 112; k = 32 + (v >> 1); c = v & 1; }
                    h = 7; qb = 63 - k; const int T = 4 * qb + 4; j1 = T - 64 * c; j0 = j1 - 64 < 0 ? 0 : j1 - 64; slot = 4 * k + c; }
                else if (u < 224) { h = 7; qb = 15 - (u - 208); j0 = 0; j1 = 4 * qb + 4; }
                else { const int k = u - 224; h = 5 - (k >> 6); qb = 63 - (k & 63); j0 = 0; j1 = 4 * qb + 4; }
                att::dsa_unit(F.lds, h, qb, j0, j1, slot, (const bf16_t*)(ws + WS_Q), (const bf16_t*)(ws + WS_K), (const bf16_t*)(ws + WS_VT), (const unsigned short*)(ws + WS_MASK), (const bf16_t*)(ws + WS_SG), (bf16_t*)(ws + WS_H),
                              (bf16_t*)(ws + WS_PARTO), (float*)(ws + WS_PARTML), knb);
            }
            SEAM(pb + 9); }
        if (EN(13) && RUN(pb + 10)) { SITE_BEGIN();
            att::dsa_merge(F.bid, F.G, F.tid, (const bf16_t*)(ws + WS_PARTO), (const float*)(ws + WS_PARTML), (const bf16_t*)(ws + WS_SG), (bf16_t*)(ws + WS_H));
            SEAM(pb + 10); }
        if (EN(12) && RUN(pb + 11)) { SITE_BEGIN(); const int l = 2 * lp + 1;
            pg8::Gemm g{(const bf16_t*)(ws + WS_H), (const bf16_t*)(ws + WS_WOUT) + (size_t)l * DM * DM, SEQ, DM, DM}; pg8::StaticOrder S; S.init(SEQ, DM, F.G, F.bid);
            if (l == 3) { epi::EpiOut<true, false> E{ws + WS_XB, ap->out, (const float*)(ws + WS_MODF) + l * 6144 + 2 * DM, F.lds + SCR_OFF}; pg8::gemm_phase(F.lds, g, S, E); }
            else { epi::EpiOut<true, true> E{ws + WS_XB, ws + WS_XB, (const float*)(ws + WS_MODF) + l * 6144 + 2 * DM, F.lds + SCR_OFF}; pg8::gemm_phase(F.lds, g, S, E); }
            SEAM(pb + 11); }
    }
#undef RUN
#undef SEAM
#undef EN
#undef SITE_BEGIN
}

#ifndef N_LAUNCH_MODE
#define N_LAUNCH_MODE 1
#endif
template <int MASK> static void launch_one(int grid, const Args& a, hipStream_t stream) {
    static bool attr = false;
    if (!attr) { attr = true; if (hipFuncSetAttribute((const void*)trunk_fwd<MASK>, hipFuncAttributeMaxDynamicSharedMemorySize, LDS_BYTES) != hipSuccess) fprintf(stderr, "kernel_launch: hipFuncSetAttribute failed\n"); }
    hipLaunchKernelGGL(trunk_fwd<MASK>, dim3(grid), dim3(512), LDS_BYTES, stream, a);
}
extern "C" void kernel_launch(void* const* d_in, const int* in_sizes, int n_in, void* d_out, int out_size, void* d_ws, size_t ws_size, hipStream_t stream) {
    static int grid = 0;
    if (grid == 0) {
        if (n_in != 18 || in_sizes[0] != SEQ * DM || out_size != SEQ * DM || ws_size < WS_END) { fprintf(stderr, "kernel_launch: unexpected shapes (n_in %d, ws %zu)\n", n_in, ws_size); grid = -1; return; }
        int dev = 0, cus = 0;
        if (hipGetDevice(&dev) != hipSuccess || hipDeviceGetAttribute(&cus, hipDeviceAttributeMultiprocessorCount, dev) != hipSuccess) { grid = -1; return; }
        grid = cus;
    }
    if (grid < 0) return;
    if (hipMemsetAsync((char*)d_ws + WS_CTL, 0, CTL_ZERO_BYTES, stream) != hipSuccess) return;
    Args a{};
    for (int i = 0; i < 18; ++i) a.in[i] = (const float*)d_in[i];
    a.out = (float*)d_out; a.ws = (unsigned char*)d_ws;
#if N_LAUNCH_MODE == 1
    a.ph_lo = 0; a.ph_hi = N_PHASES;
    launch_one<0x3fff>(grid, a, stream);
#else
    for (int p = 0; p < N_PHASES; ++p) {
        a.ph_lo = p; a.ph_hi = p + 1;
        const int r_ = p < 2 ? 0 : (p - 2) % 12; const int site = p < 2 ? p : (r_ < 10 ? 2 + r_ : (r_ == 10 ? 13 : 12));
        switch (site) {
            case 0: launch_one<1 << 0>(grid, a, stream); break; case 1: launch_one<1 << 1>(grid, a, stream); break; case 2: launch_one<1 << 2>(grid, a, stream); break;
            case 3: launch_one<1 << 3>(grid, a, stream); break; case 4: launch_one<1 << 4>(grid, a, stream); break; case 5: launch_one<1 << 5>(grid, a, stream); break;
            case 6: launch_one<1 << 6>(grid, a, stream); break; case 7: launch_one<1 << 7>(grid, a, stream); break; case 8: launch_one<1 << 8>(grid, a, stream); break;
            case 9: launch_one<1 << 9>(grid, a, stream); break; case 10: launch_one<1 << 10>(grid, a, stream); break; case 11: launch_one<1 << 11>(grid, a, stream); break;
            case 12: launch_one<1 << 12>(grid, a, stream); break;
            default: launch_one<1 << 13>(grid, a, stream); break;
        }
    }
#endif
}
```

```cpp
#include <hip/hip_runtime.h>
#include <cstdio>
#include <cstdint>

#define LAS __attribute__((address_space(3)))
#define GAS __attribute__((address_space(1)))
typedef unsigned short bf16_t;
typedef short bf16x8 __attribute__((ext_vector_type(8)));
typedef short s16x4 __attribute__((ext_vector_type(4)));
typedef float f32x2 __attribute__((ext_vector_type(2)));
typedef float f32x4 __attribute__((ext_vector_type(4)));
typedef float f32x16 __attribute__((ext_vector_type(16)));
typedef unsigned u32x2 __attribute__((ext_vector_type(2)));
typedef unsigned u32x4 __attribute__((ext_vector_type(4)));

constexpr int SEQ = 16384, DM = 2048, HALFW = 1024, HD = 128, NH = 8;
constexpr int EV_N = 6144, OD_SRC_N = 7752, OD_N = 7936;
constexpr int EV_MAIN = 5120, OD_MAIN = 6912;
constexpr float EPS = 1e-6f;
constexpr float SCALE = 0.08838834764831845f;
constexpr float LOG2E = 1.4426950408889634f;
constexpr float C2 = SCALE * LOG2E;
constexpr float NEG_INF = -__builtin_inff();

constexpr size_t MiB = 1u << 20;
constexpr size_t WS_CTL = 0, CTL_ZERO_BYTES = 1 * MiB, CTL_KMEAN_OFF = 262144;
constexpr size_t WS_MODP = 1 * MiB, WS_MODF = 2 * MiB, WS_KMEAN = 3 * MiB, WS_PWT = 4 * MiB;
constexpr size_t WS_WOUT = 8 * MiB, WS_WEV = 40 * MiB, WS_WOD = 88 * MiB;
constexpr size_t WS_H = 150 * MiB, WS_SG = 214 * MiB, WS_Q = 278 * MiB, WS_K = 310 * MiB, WS_VT = 342 * MiB;
constexpr size_t WS_UA = 374 * MiB, WS_D = 406 * MiB, WS_LIST = 438 * MiB, WS_PARTO = 470 * MiB, WS_PARTML = 566 * MiB;
constexpr size_t WS_QI = 374 * MiB, WS_KI = 390 * MiB, WS_WI = 392 * MiB, WS_U = 394 * MiB, WS_MASK = 426 * MiB;
constexpr size_t WS_XB = 570 * MiB;
constexpr size_t WS_END = 634 * MiB;
constexpr int CW_BAR = 4096;
constexpr int CW_CNT = 16384;
constexpr int CW_KIMAX = 16384 + 2 * 512 * 16;
constexpr int CW_DQ = CW_KIMAX + 64;
static_assert((CW_DQ + 64) * 4 <= (int)CTL_ZERO_BYTES, "ctl");

constexpr int RING_BYTES = 131072;
constexpr int SCR_OFF = RING_BYTES;
constexpr int LDS_BYTES = 163840;
constexpr int MISC_OFF = LDS_BYTES - 256;

__device__ __forceinline__ unsigned cvt_pk_bf16(float lo, float hi) { unsigned r; asm volatile("v_cvt_pk_bf16_f32 %0, %1, %2" : "=v"(r) : "v"(lo), "v"(hi)); return r; }
__device__ __forceinline__ float bf2f(unsigned short b) { return __uint_as_float((unsigned)b << 16); }
__device__ __forceinline__ float bflo(unsigned w) { return __uint_as_float(w << 16); }
__device__ __forceinline__ float bfhi(unsigned w) { return __uint_as_float(w & 0xffff0000u); }
__device__ __forceinline__ int crow(int r, int hi) { return (r & 3) + 8 * (r >> 2) + 4 * hi; }
__device__ __forceinline__ float fast_exp2(float x) { return __builtin_amdgcn_exp2f(x); }
__device__ __forceinline__ float sigmoidf_(float x) { return __builtin_amdgcn_rcpf(1.0f + __expf(-x)); }
__device__ __forceinline__ float siluf_(float x) { return x * __builtin_amdgcn_rcpf(1.0f + __expf(-x)); }
#define LDS_WAIT() asm volatile("s_waitcnt lgkmcnt(0)" ::: "memory")
#define VM_WAIT() asm volatile("s_waitcnt vmcnt(0)" ::: "memory")
#define WG_BAR() do { asm volatile("s_waitcnt lgkmcnt(0)" ::: "memory"); __builtin_amdgcn_s_barrier(); asm volatile("" ::: "memory"); } while (0)

__device__ __forceinline__ int opaque_tid() { int t = threadIdx.x; asm volatile("" : "+v"(t)); return t; }

#define XB_TMO      128
#define XB_XCNT(j)  (256  + 64 * (j))
#define XB_XSUB(j)  (1280 + 64 * (j))
#define XB_XGEN(j)  (2304 + 64 * (j))
#define XB_TOP      3328
#define XB_TOPGEN   3392
#define XCD_BAR_WORDS 3456
#define XB_SPIN_CAP (1u << 18)

__device__ __forceinline__ unsigned xb_ld(unsigned* p)              { return __hip_atomic_load(p, __ATOMIC_RELAXED, __HIP_MEMORY_SCOPE_AGENT); }
__device__ __forceinline__ unsigned xb_add(unsigned* p, unsigned v) { return __hip_atomic_fetch_add(p, v, __ATOMIC_RELAXED, __HIP_MEMORY_SCOPE_AGENT); }
__device__ __forceinline__ unsigned xb_xcc_id() { return (unsigned)__builtin_amdgcn_s_getreg((3 << 11) | 20) & 0xFu; }
#define XB_SPIN(cond, bar) do { unsigned _sp = 0; while (cond) { __builtin_amdgcn_s_sleep(1); \
    if ((++_sp & 255u) == 0u) { if (xb_ld(&(bar)[XB_TMO])) break; if (_sp > XB_SPIN_CAP) { atomicAdd(&(bar)[XB_TMO], 1u); break; } } } } while (0)

struct XcdBarrier {
    unsigned* bar; unsigned x;
    volatile LAS unsigned* st;
};

__device__ __forceinline__ XcdBarrier xcd_barrier_post(unsigned* bar, volatile LAS unsigned* st) {
    XcdBarrier b; b.bar = bar; b.x = xb_xcc_id(); b.st = st;
    if (threadIdx.x == 0) (void)xb_add(&bar[XB_XCNT(b.x)], 1u);
    return b;
}
__device__ __forceinline__ void xcd_barrier_complete(unsigned* bar, unsigned x, unsigned& nloc, unsigned& nx) {
    const unsigned G = gridDim.x * gridDim.y * gridDim.z;
    unsigned sum, cnt, mine, sp = 0u;
    for (;;) {
        sum = 0u; cnt = 0u; mine = 0u;
#pragma unroll
        for (unsigned j = 0; j < 16; ++j) { const unsigned c = xb_ld(&bar[XB_XCNT(j)]); sum += c; cnt += (c > 0u) ? 1u : 0u; mine = (j == x) ? c : mine; }
        if (sum == G) break;
        __builtin_amdgcn_s_sleep(1);
        if ((++sp & 255u) == 0u) { if (xb_ld(&bar[XB_TMO])) break; if (sp > XB_SPIN_CAP) { atomicAdd(&bar[XB_TMO], 1u); break; } }
    }
    nloc = mine > 0u ? mine : 1u; nx = cnt > 0u ? cnt : 1u;
}

__device__ __forceinline__ void xcd_barrier(const XcdBarrier& b) {
    asm volatile("s_waitcnt vmcnt(0)" ::: "memory");
    __syncthreads();
    if (threadIdx.x == 0) {
        unsigned* bar = b.bar;
        __builtin_amdgcn_s_waitcnt(0);
        unsigned nloc = b.st[0], nx = b.st[1];
        if (nloc == 0u) { xcd_barrier_complete(bar, b.x, nloc, nx); b.st[0] = nloc; b.st[1] = nx; }
        const unsigned old = xb_add(&bar[XB_XSUB(b.x)], 1u);
        const unsigned gen = old / nloc;
        if (old + 1u == (gen + 1u) * nloc) {
            __builtin_amdgcn_fence(__ATOMIC_RELEASE, "agent");
            asm volatile("s_waitcnt vmcnt(0)" ::: "memory");
            const unsigned og = xb_add(&bar[XB_TOP], 1u);
            const unsigned tg = og / nx;
            if (og + 1u == (tg + 1u) * nx) xb_add(&bar[XB_TOPGEN], 1u);
            else XB_SPIN(xb_ld(&bar[XB_TOPGEN]) == tg, bar);
            __builtin_amdgcn_fence(__ATOMIC_ACQUIRE, "agent");
            xb_add(&bar[XB_XGEN(b.x)], 1u);
            asm volatile("s_waitcnt vmcnt(0)" ::: "memory");
        } else {
            XB_SPIN(xb_ld(&bar[XB_XGEN(b.x)]) == gen, bar);
            __builtin_amdgcn_fence(__ATOMIC_ACQUIRE, "agent");
            asm volatile("s_waitcnt vmcnt(0)" ::: "memory");
        }
    }
    __syncthreads();
}

namespace pg8 {
constexpr int BM = 256, BK = 64, HALF = 128, HTB = HALF * BK * 2, STAGE_BYTES = 8 * HTB, NXCD = 8, WGM = 8;
__host__ __device__ __forceinline__ int lds_byte(int r, int c) { const int st = (r >> 4) * 2 + (c >> 5), rr = r & 15, cc = c & 31, ob = rr * 64 + cc * 2; return st * 1024 + (ob ^ (((ob >> 9) & 1) << 5)); }
__host__ __device__ __forceinline__ void stage_rc(int b, int& R, int& C) { const int st = b / 1024, sb = b % 1024, swz = sb ^ (((sb >> 9) & 1) << 5); R = (st >> 1) * 16 + swz / 64; C = (st & 1) * 32 + (swz % 64) / 2; }
__host__ __device__ __forceinline__ int perm32(int rho) { const int n = rho >> 4, i = rho & 15; return 8 * (i >> 2) + 4 * n + (i & 3); }
struct Unit { int pm, pn; };
struct Gemm { const bf16_t* A; const bf16_t* Bt; int M, N, K; };
struct StaticOrder {
    int nM, nN, nwg, G, c;
    __device__ void init(int M, int N, int G_, int c_) { nM = M / BM; nN = N / BM; nwg = nM * nN; G = G_; c = c_; }
    __device__ bool next(int i, Unit& u) const {
        const long L = (long)i * G + c; if (L >= nwg) return false;
        int wgid = (int)L; { const int q = nwg / NXCD, r = nwg % NXCD, xcd = wgid % NXCD, off = wgid / NXCD; wgid = (xcd < r ? xcd * (q + 1) : r * (q + 1) + (xcd - r) * q) + off; }
        const int nig = WGM * nN, gid = wgid / nig, fm = gid * WGM, gsz = (nM - fm) < WGM ? (nM - fm) : WGM;
        u.pm = fm + ((wgid % nig) % gsz); u.pn = (wgid % nig) / gsz; return true;
    }
};
struct PoolOrder {
    int G, c;
    __device__ bool next(int i, Unit& u) const { const int L = i * G + c; if (L >= 256) return false; u.pm = L; u.pn = L >> 6; return true; }
};

template <class Epi, class Sched>
__device__ __forceinline__ void gemm_phase(LAS unsigned char* lds, const Gemm g, const Sched& S, const Epi& E) {
    const int tid = opaque_tid(), wid = __builtin_amdgcn_readfirstlane(tid >> 6), lane = tid & 63, wr = wid >> 2, wc = wid & 3, fr = lane & 15, fq = lane >> 4;
    int K = g.K; asm volatile("" : "+s"(K));
    const int nt = K / BK;
    unsigned voffA, voffB;
    { int R, C; stage_rc(tid * 16, R, C); const int Rb = Epi::PERM ? ((R & ~31) + perm32(R & 31)) : R;
      voffA = (unsigned)(R * K + C) * 2u; voffB = (unsigned)(Rb * K + C) * 2u; }
    const size_t pstep = (size_t)64 * K * 2;
    const size_t kstep = (size_t)(BK * 2);
    const size_t hstep = (size_t)HALF * K * 2;
    const size_t tstep = 2 * hstep;
    const unsigned ldsw = (unsigned)wid * 1024u;
    const int aoff = lds_byte(wr * 64 + fr, fq * 8), boff = lds_byte(wc * 32 + fr, fq * 8);
#define PG8_SA(b, h) (((b) * 2 + (h)) * HTB)
#define PG8_SB(b, h) ((4 + (b) * 2 + (h)) * HTB)
#define PG8_STAGE(bufoff, gbase, voff) do { _Pragma("unroll") for (int _i = 0; _i < 2; ++_i) \
        __builtin_amdgcn_global_load_lds((const unsigned*)((const char*)(gbase) + _i * pstep + (voff)), (LAS unsigned*)(lds + (bufoff) + ldsw + _i * 8192), 16, 0, 0); } while (0)
#define PG8_LDA(dst, b, h) do { _Pragma("unroll") for (int m = 0; m < 4; ++m) _Pragma("unroll") for (int k = 0; k < 2; ++k) dst[m][k] = *(const LAS bf16x8*)(lds + PG8_SA(b, h) + aoff + m * 2048 + k * 1024); } while (0)
#define PG8_LDB(dst, b, h) do { _Pragma("unroll") for (int n = 0; n < 2; ++n) _Pragma("unroll") for (int k = 0; k < 2; ++k) dst[n][k] = *(const LAS bf16x8*)(lds + PG8_SB(b, h) + boff + n * 2048 + k * 1024); } while (0)
#define PG8_MMA(ai, bj, At, Bt) do { __builtin_amdgcn_s_setprio(1); _Pragma("unroll") for (int m = 0; m < 4; ++m) _Pragma("unroll") for (int n = 0; n < 2; ++n) _Pragma("unroll") for (int k = 0; k < 2; ++k) \
        acc[ai][bj][m][n] = __builtin_amdgcn_mfma_f32_16x16x32_bf16(Bt[n][k], At[m][k], acc[ai][bj][m][n], 0, 0, 0); __builtin_amdgcn_s_setprio(0); } while (0)
#define PG8_WAIT_V(n) asm volatile("s_waitcnt vmcnt(" #n ")" ::: "memory")
#define PG8_WAIT_L(n) asm volatile("s_waitcnt lgkmcnt(" #n ")" ::: "memory")
#define PG8_BAR __builtin_amdgcn_s_barrier()
#define PG8_SCHED __builtin_amdgcn_sched_barrier(0)
    Unit cur, nxt; int ui = 0;
    if (!S.next(0, cur)) return;
    f32x4 acc[2][2][4][2];
#pragma unroll
    for (int a = 0; a < 2; ++a)
#pragma unroll
        for (int b = 0; b < 2; ++b)
#pragma unroll
            for (int m = 0; m < 4; ++m)
#pragma unroll
                for (int n = 0; n < 2; ++n) acc[a][b][m][n] = (f32x4){0.f, 0.f, 0.f, 0.f};
    bf16x8 At[4][2], B0[2][2], B1[2][2];
    const char* cA = (const char*)g.A + (size_t)cur.pm * tstep; const char* cB = (const char*)g.Bt + (size_t)cur.pn * tstep;
#define PG8_FENCE asm volatile("" : "+v"(voffA), "+v"(voffB))
    PG8_FENCE; PG8_STAGE(PG8_SB(0, 0), cB, voffB); PG8_FENCE; PG8_STAGE(PG8_SB(0, 1), cB + hstep, voffB); PG8_FENCE; PG8_STAGE(PG8_SA(0, 0), cA, voffA); PG8_FENCE; PG8_STAGE(PG8_SA(0, 1), cA + hstep, voffA); PG8_FENCE;
    if (wr == 1) PG8_BAR;
    PG8_WAIT_V(2); PG8_BAR;
    PG8_STAGE(PG8_SB(1, 0), cB + kstep, voffB); PG8_FENCE; PG8_STAGE(PG8_SA(1, 0), cA + kstep, voffA); PG8_FENCE; PG8_STAGE(PG8_SB(1, 1), cB + hstep + kstep, voffB); PG8_FENCE;
    PG8_WAIT_V(6); PG8_BAR;
    for (;;) {
        const bool has_next = S.next(ui + 1, nxt);
        const char* nA = has_next ? (const char*)g.A + (size_t)nxt.pm * tstep : cA; const char* nB = has_next ? (const char*)g.Bt + (size_t)nxt.pn * tstep : cB;
        for (int t = 0; t < nt; t += 2) {
            const bool last = (t == nt - 2);
            const char* a1 = cA + (size_t)(t + 1) * kstep;
            const char* a2 = last ? nA : cA + (size_t)(t + 2) * kstep; const char* b2 = last ? nB : cB + (size_t)(t + 2) * kstep;
            const char* a3 = a2 + kstep; const char* b3 = b2 + kstep;
            PG8_LDB(B0, 0, 0); PG8_LDB(B1, 0, 1); PG8_SCHED; PG8_LDA(At, 0, 0); PG8_STAGE(PG8_SA(1, 1), a1 + hstep, voffA);
            PG8_WAIT_V(8); PG8_WAIT_L(0); PG8_BAR; PG8_MMA(0, 0, At, B0); PG8_MMA(0, 1, At, B1); PG8_BAR; PG8_SCHED;
            PG8_LDA(At, 0, 1); PG8_STAGE(PG8_SB(0, 0), b2, voffB); PG8_STAGE(PG8_SB(0, 1), b2 + hstep, voffB); PG8_STAGE(PG8_SA(0, 0), a2, voffA);
            PG8_WAIT_V(8); PG8_WAIT_L(0); PG8_BAR; PG8_MMA(1, 0, At, B0); PG8_MMA(1, 1, At, B1); PG8_BAR; PG8_SCHED;
            PG8_LDB(B0, 1, 0); PG8_LDB(B1, 1, 1); PG8_SCHED; PG8_LDA(At, 1, 0); PG8_STAGE(PG8_SA(0, 1), a2 + hstep, voffA);
            PG8_WAIT_V(8); PG8_WAIT_L(0); PG8_BAR; PG8_MMA(0, 0, At, B0); PG8_MMA(0, 1, At, B1); PG8_BAR; PG8_SCHED;
            PG8_LDA(At, 1, 1); PG8_STAGE(PG8_SB(1, 0), b3, voffB); PG8_STAGE(PG8_SB(1, 1), b3 + hstep, voffB); PG8_STAGE(PG8_SA(1, 0), a3, voffA);
            PG8_WAIT_V(8); PG8_WAIT_L(0); PG8_BAR; PG8_MMA(1, 0, At, B0); PG8_MMA(1, 1, At, B1); PG8_BAR; PG8_SCHED;
        }
        if (wr == 0) PG8_BAR;
        E(acc, cur, wr, wc, fr, fq, wid, lane);
        if (!has_next) break;
#pragma unroll
        for (int a = 0; a < 2; ++a)
#pragma unroll
            for (int b = 0; b < 2; ++b)
#pragma unroll
                for (int m = 0; m < 4; ++m)
#pragma unroll
                    for (int n = 0; n < 2; ++n) acc[a][b][m][n] = (f32x4){0.f, 0.f, 0.f, 0.f};
        cur = nxt; cA = nA; cB = nB; ++ui;
        if (wr == 1) PG8_BAR;
    }
    PG8_WAIT_V(0);
    PG8_BAR;
#undef PG8_SA
#undef PG8_FENCE
#undef PG8_SB
#undef PG8_STAGE
#undef PG8_LDA
#undef PG8_LDB
#undef PG8_MMA
#undef PG8_WAIT_V
#undef PG8_WAIT_L
#undef PG8_BAR
#undef PG8_SCHED
}
}

namespace epi {
using pg8::Unit;
__device__ __forceinline__ void st8(bf16_t* p, const f32x4 v0, const f32x4 v1) {
    u32x4 w; w.x = cvt_pk_bf16(v0[0], v0[1]); w.y = cvt_pk_bf16(v0[2], v0[3]); w.z = cvt_pk_bf16(v1[0], v1[1]); w.w = cvt_pk_bf16(v1[2], v1[3]);
    *(u32x4*)p = w;
}
__device__ __forceinline__ float sumsq8(const f32x4 a, const f32x4 b) { return (a[0] * a[0] + a[1] * a[1]) + (a[2] * a[2] + a[3] * a[3]) + (b[0] * b[0] + b[1] * b[1]) + (b[2] * b[2] + b[3] * b[3]); }
__device__ __forceinline__ f32x4 silu4(const f32x4 v) { return (f32x4){siluf_(v[0]), siluf_(v[1]), siluf_(v[2]), siluf_(v[3])}; }

template <bool KMEAN_>
__device__ __forceinline__ void qk_norm_store(const f32x4 (&acc)[2][2][4][2], const Unit& u, int wr, int wc, int fr, int fq, int wid, int lane,
                                              LAS unsigned char* scr, const float* gn, bf16_t* dst, int head0, float* kmean) {
    LAS float* P = (LAS float*)scr;
#pragma unroll
    for (int ai = 0; ai < 2; ++ai)
#pragma unroll
        for (int m = 0; m < 4; ++m)
#pragma unroll
            for (int bj = 0; bj < 2; ++bj) {
                float ss = sumsq8(acc[ai][bj][m][0], acc[ai][bj][m][1]);
                ss += __shfl_xor(ss, 16); ss += __shfl_xor(ss, 32);
                if (fq == 0) P[((ai * 128 + wr * 64 + m * 16 + fr) * 2 + bj) * 4 + wc] = ss;
                __builtin_amdgcn_sched_barrier(0);
            }
    WG_BAR();
    const f32x4 g0 = *(const f32x4*)(gn + 32 * wc + 8 * fq), g1 = *(const f32x4*)(gn + 32 * wc + 8 * fq + 4);
#pragma unroll
    for (int ai = 0; ai < 2; ++ai)
#pragma unroll
        for (int m = 0; m < 4; ++m)
#pragma unroll
            for (int bj = 0; bj < 2; ++bj) {
                const int rl = ai * 128 + wr * 64 + m * 16 + fr;
                const f32x4 p4 = *(const LAS f32x4*)&P[(rl * 2 + bj) * 4];
                const float rstd = __builtin_amdgcn_rsqf(((p4[0] + p4[1]) + (p4[2] + p4[3])) * (1.0f / 128.0f) + EPS);
                const f32x4 v0 = acc[ai][bj][m][0] * rstd * g0, v1 = acc[ai][bj][m][1] * rstd * g1;
                st8(dst + ((size_t)(head0 + bj) * SEQ + (size_t)(u.pm * 256 + rl)) * HD + 32 * wc + 8 * fq, v0, v1);
                __builtin_amdgcn_sched_barrier(0);
            }
    if (KMEAN_) {
        __builtin_amdgcn_sched_barrier(0);
#pragma unroll
        for (int bj = 0; bj < 2; ++bj)
#pragma unroll
            for (int n = 0; n < 2; ++n) {
                f32x4 c4 = (f32x4){0.f, 0.f, 0.f, 0.f};
#pragma unroll
                for (int ai = 0; ai < 2; ++ai)
#pragma unroll
                    for (int m = 0; m < 4; ++m) {
                        const int rl = ai * 128 + wr * 64 + m * 16 + fr;
                        const f32x4 p4 = *(const LAS f32x4*)&P[(rl * 2 + bj) * 4];
                        const float rstd = __builtin_amdgcn_rsqf(((p4[0] + p4[1]) + (p4[2] + p4[3])) * (1.0f / 128.0f) + EPS);
                        c4 += acc[ai][bj][m][n] * rstd;
                    }
                c4 = c4 * (n == 0 ? g0 : g1);
#pragma unroll
                for (int e = 0; e < 4; ++e) {
                    float s = c4[e];
                    s += __shfl_xor(s, 1); s += __shfl_xor(s, 2); s += __shfl_xor(s, 4); s += __shfl_xor(s, 8);
                    if (fr == 0) atomicAdd(kmean + ((size_t)(head0 + bj) * 64 + u.pm) * HD + 32 * wc + 8 * fq + 4 * n + e, s * (1.0f / 256.0f));
                }
                __builtin_amdgcn_sched_barrier(0);
            }
    }
}

struct EpiEven {
    static constexpr bool PERM = true;
    unsigned char* ws; float* KMEAN; const float *qn, *kn; LAS unsigned char* scr;
    __device__ __forceinline__ void operator()(const f32x4 (&acc)[2][2][4][2], const Unit& u, int wr, int wc, int fr, int fq, int wid, int lane) const {
        asm volatile("" : "+v"(fr), "+v"(fq), "+v"(lane));
        const int pn = u.pn, row0 = u.pm * 256 + wr * 64 + fr;
        bf16_t* UA = (bf16_t*)(ws + WS_UA); bf16_t* Q = (bf16_t*)(ws + WS_Q); bf16_t* K = (bf16_t*)(ws + WS_K); bf16_t* SG = (bf16_t*)(ws + WS_SG);
        if (pn < 4) {
#pragma unroll
            for (int ai = 0; ai < 2; ++ai)
#pragma unroll
                for (int m = 0; m < 4; ++m) { bf16_t* rp = UA + (size_t)(row0 + ai * 128 + m * 16) * HALFW + pn * 256 + wc * 32 + 8 * fq;
#pragma unroll
                    for (int bj = 0; bj < 2; ++bj) st8(rp + bj * 128, acc[ai][bj][m][0], acc[ai][bj][m][1]); }
        } else if (pn < 8) {
            qk_norm_store<false>(acc, u, wr, wc, fr, fq, wid, lane, scr, qn, Q, 2 * (pn - 4), nullptr);
        } else if (pn < 12) {
            qk_norm_store<true>(acc, u, wr, wc, fr, fq, wid, lane, scr, kn, K, 2 * (pn - 8), KMEAN);
        } else {
#pragma unroll
            for (int ai = 0; ai < 2; ++ai)
#pragma unroll
                for (int m = 0; m < 4; ++m) { bf16_t* rp = SG + (size_t)(row0 + ai * 128 + m * 16) * DM + (pn - 12) * 256 + wc * 32 + 8 * fq;
#pragma unroll
                    for (int bj = 0; bj < 2; ++bj) st8(rp + bj * 128, silu4(acc[ai][bj][m][0]), silu4(acc[ai][bj][m][1])); }
        }
    }
};

struct EpiOdd {
    static constexpr bool PERM = true;
    unsigned char* ws; unsigned* KIMAX; const float *qn, *kn; LAS unsigned char* scr;
    __device__ __forceinline__ void operator()(const f32x4 (&acc)[2][2][4][2], const Unit& u, int wr, int wc, int fr, int fq, int wid, int lane) const {
        asm volatile("" : "+v"(fr), "+v"(fq), "+v"(lane));
        const int pn = u.pn, row0 = u.pm * 256 + wr * 64 + fr;
        bf16_t* Q = (bf16_t*)(ws + WS_Q); bf16_t* K = (bf16_t*)(ws + WS_K); bf16_t* QI = (bf16_t*)(ws + WS_QI); bf16_t* KI = (bf16_t*)(ws + WS_KI); bf16_t* U = (bf16_t*)(ws + WS_U); bf16_t* SG = (bf16_t*)(ws + WS_SG); float* WI = (float*)(ws + WS_WI);
        if (pn < 4) {
            qk_norm_store<false>(acc, u, wr, wc, fr, fq, wid, lane, scr, qn, Q, 2 * pn, nullptr);
        } else if (pn < 8) {
            qk_norm_store<false>(acc, u, wr, wc, fr, fq, wid, lane, scr, kn, K, 2 * (pn - 4), nullptr);
        } else if (pn < 10) {
#pragma unroll
            for (int ai = 0; ai < 2; ++ai)
#pragma unroll
                for (int m = 0; m < 4; ++m) { bf16_t* rp = QI + (size_t)(row0 + ai * 128 + m * 16) * 512 + (pn - 8) * 256 + wc * 32 + 8 * fq;
#pragma unroll
                    for (int bj = 0; bj < 2; ++bj) {
                        st8(rp + bj * 128, acc[ai][bj][m][0], acc[ai][bj][m][1]);
                    } }
        } else if (pn == 10) {
            if (wc < 2) {
                float mx = 0.f;
#pragma unroll
                for (int ai = 0; ai < 2; ++ai)
#pragma unroll
                    for (int m = 0; m < 4; ++m) {
                        st8(KI + (size_t)(row0 + ai * 128 + m * 16) * 64 + wc * 32 + 8 * fq, acc[ai][0][m][0], acc[ai][0][m][1]);
                        mx = fmaxf(mx, sumsq8(acc[ai][0][m][0], acc[ai][0][m][1]));
                    }
                mx = fmaxf(mx, __shfl_xor(mx, 1)); mx = fmaxf(mx, __shfl_xor(mx, 2)); mx = fmaxf(mx, __shfl_xor(mx, 4)); mx = fmaxf(mx, __shfl_xor(mx, 8));
                if (fr == 0) atomicMax(KIMAX + wc * 4 + fq, __float_as_uint(mx));
            } else if (wc == 2 && fq == 0) {
                const float s = 0.35355339059327373f;
#pragma unroll
                for (int ai = 0; ai < 2; ++ai)
#pragma unroll
                    for (int m = 0; m < 4; ++m) { float* wp = WI + (size_t)(row0 + ai * 128 + m * 16) * 8;
                        *(f32x4*)wp = acc[ai][0][m][0] * s; *(f32x4*)(wp + 4) = acc[ai][0][m][1] * s; }
            }
        } else if (pn < 19) {
            const int j = pn - 11;
#pragma unroll
            for (int ai = 0; ai < 2; ++ai)
#pragma unroll
                for (int m = 0; m < 4; ++m) {
                    f32x4 u0, u1;
#pragma unroll
                    for (int e = 0; e < 4; ++e) { u0[e] = acc[ai][0][m][0][e] * sigmoidf_(acc[ai][1][m][0][e]); u1[e] = acc[ai][0][m][1][e] * sigmoidf_(acc[ai][1][m][1][e]); }
                    st8(U + (size_t)(row0 + ai * 128 + m * 16) * HALFW + j * 128 + wc * 32 + 8 * fq, u0, u1);
                }
        } else {
#pragma unroll
            for (int ai = 0; ai < 2; ++ai)
#pragma unroll
                for (int m = 0; m < 4; ++m) { bf16_t* rp = SG + (size_t)(row0 + ai * 128 + m * 16) * DM + (pn - 19) * 256 + wc * 32 + 8 * fq;
#pragma unroll
                    for (int bj = 0; bj < 2; ++bj) st8(rp + bj * 128, silu4(acc[ai][bj][m][0]), silu4(acc[ai][bj][m][1])); }
        }
    }
};

struct EpiVT {
    static constexpr bool PERM = true;
    bf16_t* VT;
    __device__ __forceinline__ void operator()(const f32x4 (&acc)[2][2][4][2], const Unit& u, int wr, int wc, int fr, int fq, int wid, int lane) const {
        asm volatile("" : "+v"(fr), "+v"(fq), "+v"(lane));
        const int row0 = u.pm * 256 + wr * 64 + fr;
#pragma unroll
        for (int ai = 0; ai < 2; ++ai)
#pragma unroll
            for (int m = 0; m < 4; ++m) { bf16_t* rp = VT + (size_t)(row0 + ai * 128 + m * 16) * SEQ + u.pn * 256 + wc * 32 + 8 * fq;
#pragma unroll
                for (int bj = 0; bj < 2; ++bj) st8(rp + bj * 128, acc[ai][bj][m][0], acc[ai][bj][m][1]); }
    }
};

struct EpiPool {
    static constexpr bool PERM = true;
    const float* pscale; const bf16_t* SG; bf16_t* YG;
    __device__ __forceinline__ void operator()(const f32x4 (&acc)[2][2][4][2], const Unit& u, int wr, int wc, int fr, int fq, int wid, int lane) const {
        asm volatile("" : "+v"(fr), "+v"(fq), "+v"(lane));
        const int row0 = (u.pm & 63) * 256 + wr * 64 + fr;
#pragma unroll
        for (int bj = 0; bj < 2; ++bj) {
            const int col = u.pn * 256 + bj * 128 + wc * 32 + 8 * fq;
            u32x4 gv[1][2][4];
#pragma unroll
            for (int ai = 0; ai < 2; ++ai)
#pragma unroll
                for (int m = 0; m < 4; ++m) gv[0][ai][m] = *(const u32x4*)(SG + (size_t)(row0 + ai * 128 + m * 16) * DM + col);
            const f32x4 p0 = *(const f32x4*)(pscale + col), p1 = *(const f32x4*)(pscale + col + 4);
            __builtin_amdgcn_sched_barrier(0);
#pragma unroll
            for (int ai = 0; ai < 2; ++ai)
#pragma unroll
                for (int m = 0; m < 4; ++m) { const size_t o = (size_t)(row0 + ai * 128 + m * 16) * DM + col;
                    const u32x4 g = gv[0][ai][m];
                    const f32x4 g0 = (f32x4){bflo(g.x), bfhi(g.x), bflo(g.y), bfhi(g.y)}, g1 = (f32x4){bflo(g.z), bfhi(g.z), bflo(g.w), bfhi(g.w)};
                    st8(YG + o, acc[ai][bj][m][0] * p0 * g0, acc[ai][bj][m][1] * p1 * g1); }
            __builtin_amdgcn_sched_barrier(0);
        }
    }
};

template <bool IN_BF, bool OUT_BF>
struct EpiOut {
    static constexpr bool PERM = true;
    const void* xin; void* xout; const float* gate; LAS unsigned char* scr;
    __device__ __forceinline__ void operator()(const f32x4 (&acc)[2][2][4][2], const Unit& u, int wr, int wc, int fr, int fq, int wid, int lane) const {
        asm volatile("" : "+v"(fr), "+v"(fq), "+v"(lane));
        LAS unsigned char* st = scr + wid * 2304;
        const int lr = lane >> 3, lp = lane & 7;
        const int rowb = u.pm * 256 + wr * 64, colb = u.pn * 256 + 64 * wc;
        f32x4 g[2][2];
#pragma unroll
        for (int bj = 0; bj < 2; ++bj)
#pragma unroll
            for (int n = 0; n < 2; ++n) g[bj][n] = *(const f32x4*)(gate + colb + 32 * bj + 8 * fq + 4 * n);
        u32x4 xa[4], xb[4], xc[4];
#define EO_RT(k) (rowb + ((k) >> 2) * 128 + ((k) & 3) * 16)
#define EO_LD(buf, k) do { if (IN_BF) { _Pragma("unroll") for (int j = 0; j < 2; ++j) buf[j] = *(const u32x4*)((const bf16_t*)xin + (size_t)(EO_RT(k) + lr + 8 * j) * DM + colb + 8 * lp); } \
        else { _Pragma("unroll") for (int q = 0; q < 4; ++q) buf[q] = *(const u32x4*)((const float*)xin + (size_t)(EO_RT(k) + fr) * DM + colb + 32 * (q >> 1) + 8 * fq + 4 * (q & 1)); } \
        __builtin_amdgcn_sched_barrier(0); } while (0)
#define EO_PROC(buf, k) do { f32x4 v[2][2]; \
        if (IN_BF) { _Pragma("unroll") for (int j = 0; j < 2; ++j) *(LAS u32x4*)(st + (lr + 8 * j) * 144 + 16 * lp) = buf[j]; \
            asm volatile("" ::: "memory"); \
            _Pragma("unroll") for (int bj = 0; bj < 2; ++bj) { const u32x4 xf = *(const LAS u32x4*)(st + fr * 144 + 16 * (4 * bj + fq)); \
                v[bj][0] = (f32x4){bflo(xf.x), bfhi(xf.x), bflo(xf.y), bfhi(xf.y)} + g[bj][0] * acc[(k) >> 2][bj][(k) & 3][0]; v[bj][1] = (f32x4){bflo(xf.z), bfhi(xf.z), bflo(xf.w), bfhi(xf.w)} + g[bj][1] * acc[(k) >> 2][bj][(k) & 3][1]; } \
            asm volatile("" ::: "memory"); } \
        else { _Pragma("unroll") for (int bj = 0; bj < 2; ++bj) _Pragma("unroll") for (int n = 0; n < 2; ++n) { const u32x4 xq = buf[2 * bj + n]; \
                v[bj][n] = (f32x4){__uint_as_float(xq.x), __uint_as_float(xq.y), __uint_as_float(xq.z), __uint_as_float(xq.w)} + g[bj][n] * acc[(k) >> 2][bj][(k) & 3][n]; } } \
        if (OUT_BF) { _Pragma("unroll") for (int bj = 0; bj < 2; ++bj) { u32x4 w; w.x = cvt_pk_bf16(v[bj][0][0], v[bj][0][1]); w.y = cvt_pk_bf16(v[bj][0][2], v[bj][0][3]); w.z = cvt_pk_bf16(v[bj][1][0], v[bj][1][1]); w.w = cvt_pk_bf16(v[bj][1][2], v[bj][1][3]); \
                *(LAS u32x4*)(st + fr * 144 + 16 * (4 * bj + fq)) = w; } \
            asm volatile("" ::: "memory"); \
            _Pragma("unroll") for (int j = 0; j < 2; ++j) { const u32x4 r = *(const LAS u32x4*)(st + (lr + 8 * j) * 144 + 16 * lp); *(u32x4*)((bf16_t*)xout + (size_t)(EO_RT(k) + lr + 8 * j) * DM + colb + 8 * lp) = r; } \
            asm volatile("" ::: "memory"); } \
        else { _Pragma("unroll") for (int bj = 0; bj < 2; ++bj) { *(LAS f32x4*)(st + fr * 144 + 32 * fq) = v[bj][0]; *(LAS f32x4*)(st + fr * 144 + 32 * fq + 16) = v[bj][1]; \
                asm volatile("" ::: "memory"); \
                _Pragma("unroll") for (int j = 0; j < 2; ++j) { const f32x4 r = *(const LAS f32x4*)(st + (lr + 8 * j) * 144 + 16 * lp); *(f32x4*)((float*)xout + (size_t)(EO_RT(k) + lr + 8 * j) * DM + colb + 32 * bj + 4 * lp) = r; } \
                asm volatile("" ::: "memory"); } } \
        __builtin_amdgcn_sched_barrier(0); } while (0)
        EO_LD(xa, 0); EO_LD(xb, 1); EO_LD(xc, 2); EO_PROC(xa, 0); EO_LD(xa, 3); EO_PROC(xb, 1); EO_LD(xb, 4); EO_PROC(xc, 2); EO_LD(xc, 5); EO_PROC(xa, 3); EO_LD(xa, 6); EO_PROC(xb, 4); EO_LD(xb, 7); EO_PROC(xc, 5); EO_PROC(xa, 6); EO_PROC(xb, 7);
#undef EO_RT
#undef EO_LD
#undef EO_PROC
    }
};
}

struct Frame {
    LAS unsigned char* lds;
    unsigned* ctl;
    int tid, lane, wave, G, bid;
};
__device__ __forceinline__ float wave_sum(float v) {
#pragma unroll
    for (int o = 1; o < 64; o <<= 1) v += __shfl_xor(v, o);
    return v;
}

struct MapId { __device__ __forceinline__ int operator()(int n) const { return n; } };
__device__ __forceinline__ int tile_sigma(int n) { return (n & ~255) | (((n >> 5) & 3) << 6) | (((n >> 7) & 1) << 5) | (n & 31); }
struct MapSig { __device__ __forceinline__ int operator()(int n) const { return tile_sigma(n); } };
struct MapEven { __device__ __forceinline__ int operator()(int n) const { return n < 3072 ? n : (n < 5120 ? n + 1024 : n - 2048); } };
struct MapOdd { __device__ __forceinline__ int operator()(int n) const {
    if (n < 2048) return n;
    if (n < 2560) return 3072 + (n - 2048);
    if (n < 2816) { const int r = n - 2560; return r < 64 ? 3592 + r : (r < 72 ? 3584 + (r - 64) : -1); }
    if (n < 4864) { const int r = n - 2816, j = r >> 8, i = r & 255; return i < 128 ? 3656 + 128 * j + i : 4680 + 128 * j + (i - 128); }
    if (n < 6912) return 5704 + (n - 4864);
    return 2048 + (n - 6912); } };
template <class F>
__device__ __forceinline__ void transpose_item(const float* W, int K, int N, bf16_t* WT, LAS float* scr, int item, int ndb, int lane, F srccol) {
    const int kb = item / ndb, nb = item % ndb, k0 = 64 * kb, n0 = 32 * nb;
    const int sc = srccol(n0 + (lane & 31));
    float tv[32];
#pragma unroll
    for (int i = 0; i < 32; ++i) { const int kk = 2 * i + (lane >> 5); tv[i] = W[(size_t)(k0 + kk) * N + (sc >= 0 ? sc : 0)]; }
#pragma unroll
    for (int i = 0; i < 32; ++i) { const int kk = 2 * i + (lane >> 5); scr[kk * 33 + (lane & 31)] = sc >= 0 ? tv[i] : 0.f; }
    LDS_WAIT(); asm volatile("" ::: "memory");
    const int c = lane & 7;
#pragma unroll
    for (int j = 0; j < 4; ++j) { const int n = (lane >> 3) + 8 * j; const LAS float* s = scr + (8 * c) * 33 + n;
        u32x4 o; o.x = cvt_pk_bf16(s[0 * 33], s[1 * 33]); o.y = cvt_pk_bf16(s[2 * 33], s[3 * 33]); o.z = cvt_pk_bf16(s[4 * 33], s[5 * 33]); o.w = cvt_pk_bf16(s[6 * 33], s[7 * 33]);
        *(u32x4*)(WT + (size_t)(n0 + n) * K + k0 + 8 * c) = o; }
    LDS_WAIT(); asm volatile("" ::: "memory");
}
__device__ __forceinline__ void phase_p0a(Frame& F, const float* cvec, const float* ada_w, const float* w_out, const float* ev_w, const float* pool_w, const float* od_w, unsigned char* ws) {
    LAS float* sil = (LAS float*)(F.lds + SCR_OFF);
    float* modp = (float*)(ws + WS_MODP);
    for (int it = F.bid; it < 4 * 8 * 12; it += F.G) {
        const int jb = it % 12, ch = (it / 12) % 8, l = it / 96;
        __syncthreads();
        if (F.tid < 256) sil[F.tid] = siluf_(cvec[ch * 256 + F.tid]);
        __syncthreads();
        const float* wp = ada_w + ((size_t)l * DM + ch * 256) * 6144 + jb * 512 + F.tid;
        float a0 = 0.f, a1 = 0.f, a2 = 0.f, a3 = 0.f;
        for (int i = 0; i < 256; i += 16) {
            float v[16];
#pragma unroll
            for (int k = 0; k < 16; ++k) v[k] = wp[(size_t)(i + k) * 6144];
#pragma unroll
            for (int k = 0; k < 16; k += 4) { a0 = fmaf(sil[i + k], v[k], a0); a1 = fmaf(sil[i + k + 1], v[k + 1], a1); a2 = fmaf(sil[i + k + 2], v[k + 2], a2); a3 = fmaf(sil[i + k + 3], v[k + 3], a3); }
        }
        modp[((size_t)ch * 4 + l) * 6144 + jb * 512 + F.tid] = (a0 + a1) + (a2 + a3);
    }
    __syncthreads();
    LAS float* scr = (LAS float*)(F.lds + F.wave * 16384);
    const int gw = F.bid * 8 + F.wave, NGW = F.G * 8;
    constexpr int I_EV = 32 * 192, I_OD = 32 * 248, I_OUT = 32 * 64, I_PW = 4 * 8;
    constexpr int NIT = 2 * I_EV + 2 * I_OD + 4 * I_OUT + 8 * I_PW;
    for (int it = gw; it < NIT; it += NGW) {
        int r = it;
        if (r < 2 * I_EV) { const int e = r / I_EV; transpose_item(ev_w + (size_t)e * DM * EV_N, DM, EV_N, (bf16_t*)(ws + WS_WEV) + (size_t)e * EV_N * DM, scr, r % I_EV, 192, F.lane, MapEven()); continue; } r -= 2 * I_EV;
        if (r < 2 * I_OD) { const int e = r / I_OD; transpose_item(od_w + (size_t)e * DM * OD_SRC_N, DM, OD_SRC_N, (bf16_t*)(ws + WS_WOD) + (size_t)e * OD_N * DM, scr, r % I_OD, 248, F.lane, MapOdd()); continue; } r -= 2 * I_OD;
        if (r < 4 * I_OUT) { const int e = r / I_OUT; transpose_item(w_out + (size_t)e * DM * DM, DM, DM, (bf16_t*)(ws + WS_WOUT) + (size_t)e * DM * DM, scr, r % I_OUT, 64, F.lane, MapSig()); continue; } r -= 4 * I_OUT;
        { const int e = r / I_PW; transpose_item(pool_w + (size_t)e * 65536, 256, 256, (bf16_t*)(ws + WS_PWT) + (size_t)e * 65536, scr, r % I_PW, 8, F.lane, MapId()); }
    }
}
__device__ __forceinline__ void phase_p0b(Frame& F, const float* ada_b, unsigned char* ws) {
    const float* modp = (const float*)(ws + WS_MODP); float* modf = (float*)(ws + WS_MODF);
    for (int i = F.bid * 512 + F.tid; i < 4 * 6144; i += F.G * 512) {
        float s = ada_b[i];
#pragma unroll
        for (int c = 0; c < 8; ++c) s += modp[(size_t)c * 4 * 6144 + i];
        modf[i] = s;
    }
}

template <bool BF>
__device__ __forceinline__ void phase_norm(Frame& F, const void* xin_, const float* norm_g, const float* mod, bf16_t* H) {
    if (BF) {
        const int gw = F.bid * 8 + F.wave, NGW = F.G * 8;
        const bf16_t* xin = (const bf16_t*)xin_;
        f32x4 gs[8], sh[8];
        { f32x4 g_[8], sc_[8];
#pragma unroll
          for (int j = 0; j < 8; ++j) { const int c = 8 * F.lane + 512 * (j >> 1) + 4 * (j & 1); g_[j] = *(const f32x4*)(norm_g + c); sc_[j] = *(const f32x4*)(mod + DM + c); sh[j] = *(const f32x4*)(mod + c); }
          __builtin_amdgcn_sched_barrier(0);
#pragma unroll
          for (int j = 0; j < 8; ++j) gs[j] = g_[j] * (sc_[j] + 1.0f); }
        u32x4 w0[4], w1[4], w2[4];
        { const int r0 = gw < SEQ ? gw : SEQ - 1, r1 = gw + NGW < SEQ ? gw + NGW : SEQ - 1;
          const u32x4* xa = (const u32x4*)(xin + (size_t)r0 * DM) + F.lane; const u32x4* xb = (const u32x4*)(xin + (size_t)r1 * DM) + F.lane;
#pragma unroll
          for (int j = 0; j < 4; ++j) { w0[j] = xa[64 * j]; w1[j] = xb[64 * j]; } }
        for (int row = gw; row < SEQ; row += NGW) {
            const int rn = row + 2 * NGW < SEQ ? row + 2 * NGW : row;
            { const u32x4* xr = (const u32x4*)(xin + (size_t)rn * DM) + F.lane;
#pragma unroll
              for (int j = 0; j < 4; ++j) w2[j] = xr[64 * j]; }
            f32x4 v[8];
#pragma unroll
            for (int j = 0; j < 4; ++j) { v[2 * j] = (f32x4){bflo(w0[j].x), bfhi(w0[j].x), bflo(w0[j].y), bfhi(w0[j].y)}; v[2 * j + 1] = (f32x4){bflo(w0[j].z), bfhi(w0[j].z), bflo(w0[j].w), bfhi(w0[j].w)}; }
            float s = 0.f;
#pragma unroll
            for (int j = 0; j < 8; ++j) s += (v[j][0] * v[j][0] + v[j][1] * v[j][1]) + (v[j][2] * v[j][2] + v[j][3] * v[j][3]);
            const float rstd = __builtin_amdgcn_rsqf(wave_sum(s) * (1.0f / DM) + EPS);
            u32x4* op = (u32x4*)(H + (size_t)row * DM) + F.lane;
#pragma unroll
            for (int j = 0; j < 4; ++j) { const f32x4 y0 = v[2 * j] * rstd * gs[2 * j] + sh[2 * j], y1 = v[2 * j + 1] * rstd * gs[2 * j + 1] + sh[2 * j + 1];
                u32x4 w; w.x = cvt_pk_bf16(y0[0], y0[1]); w.y = cvt_pk_bf16(y0[2], y0[3]); w.z = cvt_pk_bf16(y1[0], y1[1]); w.w = cvt_pk_bf16(y1[2], y1[3]); op[64 * j] = w; }
#pragma unroll
            for (int j = 0; j < 4; ++j) { w0[j] = w1[j]; w1[j] = w2[j]; }
        }
        return;
    }
    const float* xin = (const float*)xin_;
    f32x4 gs[8], sh[8];
    { f32x4 g_[8], sc_[8];
#pragma unroll
      for (int j = 0; j < 8; ++j) { const int c = 4 * F.lane + 256 * j; g_[j] = *(const f32x4*)(norm_g + c); sc_[j] = *(const f32x4*)(mod + DM + c); sh[j] = *(const f32x4*)(mod + c); }
      __builtin_amdgcn_sched_barrier(0);
#pragma unroll
      for (int j = 0; j < 8; ++j) gs[j] = g_[j] * (sc_[j] + 1.0f); }
    const int gw = F.bid * 8 + F.wave, NGW = F.G * 8;
    f32x4 v[8], vn[8];
    if (gw < SEQ) { const f32x4* xr = (const f32x4*)(xin + (size_t)gw * DM) + F.lane;
#pragma unroll
        for (int j = 0; j < 8; ++j) v[j] = xr[64 * j]; }
    for (int row = gw; row < SEQ; row += NGW) {
        const int rn = row + NGW < SEQ ? row + NGW : row;
        { const f32x4* xr = (const f32x4*)(xin + (size_t)rn * DM) + F.lane;
#pragma unroll
          for (int j = 0; j < 8; ++j) vn[j] = xr[64 * j]; }
        float s = 0.f;
#pragma unroll
        for (int j = 0; j < 8; ++j) s += (v[j][0] * v[j][0] + v[j][1] * v[j][1]) + (v[j][2] * v[j][2] + v[j][3] * v[j][3]);
        const float rstd = __builtin_amdgcn_rsqf(wave_sum(s) * (1.0f / DM) + EPS);
        u32x2* op = (u32x2*)(H + (size_t)row * DM) + F.lane;
#pragma unroll
        for (int j = 0; j < 8; ++j) { const f32x4 y = v[j] * rstd * gs[j] + sh[j]; u32x2 w; w.x = cvt_pk_bf16(y[0], y[1]); w.y = cvt_pk_bf16(y[2], y[3]); op[64 * j] = w; }
#pragma unroll
        for (int j = 0; j < 8; ++j) v[j] = vn[j];
    }
}

template <int W>
__device__ __forceinline__ void pool_d_item(const bf16_t* UA, bf16_t* D, int t, int g, int c8) {
    const int n = (t + 1) < W ? (t + 1) : W;
    u32x4 uw[W];
#pragma unroll
    for (int j = 0; j < W; ++j) uw[j] = *(const u32x4*)(UA + (size_t)(j < n ? t - j : t) * HALFW + c8 * 8);
    float a[8];
#pragma unroll
    for (int e = 0; e < 8; ++e) a[e] = 0.f;
#pragma unroll
    for (int j = 0; j < W; ++j) { const float wj = j < n ? 1.0f : 0.0f; const u32x4 u = uw[j];
        a[0] = fmaf(wj, bflo(u.x), a[0]); a[1] = fmaf(wj, bfhi(u.x), a[1]); a[2] = fmaf(wj, bflo(u.y), a[2]); a[3] = fmaf(wj, bfhi(u.y), a[3]);
        a[4] = fmaf(wj, bflo(u.z), a[4]); a[5] = fmaf(wj, bfhi(u.z), a[5]); a[6] = fmaf(wj, bflo(u.w), a[6]); a[7] = fmaf(wj, bfhi(u.w), a[7]); }
    const float inv = 1.0f / (float)n; const u32x4 u0 = uw[0];
    u32x4 o;
    o.x = cvt_pk_bf16(a[0] * inv - bflo(u0.x), a[1] * inv - bfhi(u0.x)); o.y = cvt_pk_bf16(a[2] * inv - bflo(u0.y), a[3] * inv - bfhi(u0.y));
    o.z = cvt_pk_bf16(a[4] * inv - bflo(u0.z), a[5] * inv - bfhi(u0.z)); o.w = cvt_pk_bf16(a[6] * inv - bflo(u0.w), a[7] * inv - bfhi(u0.w));
    *(u32x4*)(D + ((size_t)g * SEQ + t) * 256 + (c8 & 31) * 8) = o;
}
__device__ __forceinline__ void phase_pool_d(Frame& F, const bf16_t* UA, bf16_t* D) {
    const int gw = F.bid * 8 + F.wave, NGW = F.G * 8;
    for (int it = gw; it < (SEQ / 2) * 4; it += NGW) {
        const int g = it & 3, t = 2 * (it >> 2) + (F.lane >> 5), c8 = g * 32 + (F.lane & 31);
        if (g == 0) pool_d_item<2>(UA, D, t, g, c8); else if (g == 1) pool_d_item<4>(UA, D, t, g, c8); else if (g == 2) pool_d_item<8>(UA, D, t, g, c8); else pool_d_item<16>(UA, D, t, g, c8);
    }
}

__device__ __forceinline__ bool better_(float av, int ai, float bv, int bi) { return av > bv || (av == bv && ai < bi); }
__device__ __forceinline__ void top3_insert(float v, int i, float& v0, int& i0, float& v1, int& i1, float& v2, int& i2) {
    const bool b0 = better_(v, i, v0, i0), b1 = better_(v, i, v1, i1), b2 = better_(v, i, v2, i2);
    const float n2 = b1 ? v1 : (b2 ? v : v2); const int m2 = b1 ? i1 : (b2 ? i : i2);
    const float n1 = b0 ? v0 : (b1 ? v : v1); const int m1 = b0 ? i0 : (b1 ? i : i1);
    const float n0 = b0 ? v : v0; const int m0 = b0 ? i : i0;
    v0 = n0; i0 = m0; v1 = n1; i1 = m1; v2 = n2; i2 = m2;
}
__device__ __forceinline__ void phase_top3(Frame& F, const bf16_t* Q, const float* KMEAN, unsigned* cnt, unsigned* LIST, float* PARTML, float knb) {
    const int gw = F.bid * 8 + F.wave, NGW = F.G * 8, r32 = F.lane & 31, hi = F.lane >> 5;
    for (int it = gw; it < 512 * 8; it += NGW) {
        const int tt = it >> 3, h = it & 7, own = tt >> 3;
        if (own == 0) continue;
        const int t = 32 * tt + r32;
        bf16x8 qr[8];
#pragma unroll
        for (int s = 0; s < 8; ++s) qr[s] = *(const bf16x8*)(Q + ((size_t)h * SEQ + t) * HD + 16 * s + 8 * hi);
        float v0 = NEG_INF, v1 = NEG_INF, v2 = NEG_INF; int i0 = 1000, i1 = 1001, i2 = 1002;
        const int nbt = own > 32 ? 2 : 1;
        for (int bt = 0; bt < nbt; ++bt) {
            f32x16 S = {};
            const float* kp = KMEAN + ((size_t)h * 64 + 32 * bt + r32) * HD + 8 * hi;
            f32x4 ka_[8], kb_[8];
#pragma unroll
            for (int s = 0; s < 8; ++s) { ka_[s] = *(const f32x4*)(kp + 16 * s); kb_[s] = *(const f32x4*)(kp + 16 * s + 4); }
            __builtin_amdgcn_sched_barrier(0);
#pragma unroll
            for (int s = 0; s < 8; ++s) {
                const f32x4 a = ka_[s], b = kb_[s];
                u32x4 wh; wh.x = cvt_pk_bf16(a[0], a[1]); wh.y = cvt_pk_bf16(a[2], a[3]); wh.z = cvt_pk_bf16(b[0], b[1]); wh.w = cvt_pk_bf16(b[2], b[3]);
                u32x4 wl; wl.x = cvt_pk_bf16(a[0] - bflo(wh.x), a[1] - bfhi(wh.x)); wl.y = cvt_pk_bf16(a[2] - bflo(wh.y), a[3] - bfhi(wh.y));
                wl.z = cvt_pk_bf16(b[0] - bflo(wh.z), b[1] - bfhi(wh.z)); wl.w = cvt_pk_bf16(b[2] - bflo(wh.w), b[3] - bfhi(wh.w));
                S = __builtin_amdgcn_mfma_f32_32x32x16_bf16(*(bf16x8*)&wh, qr[s], S, 0, 0, 0);
                S = __builtin_amdgcn_mfma_f32_32x32x16_bf16(*(bf16x8*)&wl, qr[s], S, 0, 0, 0);
            }
#pragma unroll
            for (int r = 0; r < 16; ++r) { const int blk = 32 * bt + crow(r, hi); const float v = blk < own ? S[r] : NEG_INF; top3_insert(v, blk, v0, i0, v1, i1, v2, i2); }
        }
        { const float pv0 = __shfl_xor(v0, 32), pv1 = __shfl_xor(v1, 32), pv2 = __shfl_xor(v2, 32); const int pi0 = __shfl_xor(i0, 32), pi1 = __shfl_xor(i1, 32), pi2 = __shfl_xor(i2, 32);
          top3_insert(pv0, pi0, v0, i0, v1, i1, v2, i2); top3_insert(pv1, pi1, v0, i0, v1, i1, v2, i2); top3_insert(pv2, pi2, v0, i0, v1, i1, v2, i2); }
        float ss = 0.f;
#pragma unroll
        for (int s = 0; s < 8; ++s)
#pragma unroll
            for (int e_ = 0; e_ < 8; ++e_) { const float v = bf2f((unsigned short)qr[s][e_]); ss = fmaf(v, v, ss); }
        ss += __shfl_xor(ss, 32);
        const float rowb = sqrtf(ss) * knb, sl = exp2f(-(float)(h + 1)) / SCALE;
        if (hi == 0) {
            const int nv = own < 3 ? own : 3;
            const int idx3[3] = {i0, i1, i2};
            int tt = t; asm volatile("" : "+v"(tt));
#pragma unroll
            for (int r = 0; r < 3; ++r) if (r < nv) {
                const int ib = idx3[r], dmin = tt - (256 * ib + 255);
                if ((2.0f * rowb - sl * (float)dmin) * C2 < -48.0f) { float ne_ = -1e30f, ze_ = 0.f; asm volatile("" : "+v"(ne_), "+v"(ze_)); *(f32x2*)(PARTML + (((size_t)h * SEQ + tt) * 3 + r) * 2) = (f32x2){ne_, ze_}; }
                else { const unsigned s = atomicAdd(cnt + (h * 64 + ib) * 16, 1u); LIST[((size_t)h * 64 + ib) * SEQ + s] = ((unsigned)tt << 2) | (unsigned)r; }
            }
        }
    }
}

namespace att {
constexpr int KPITCH = 272, VPITCH = 136, KBUFB = 64 * KPITCH, VBUFB = 128 * VPITCH, BUFB = KBUFB + VBUFB;
static_assert(2 * BUFB <= RING_BYTES, "lds");
constexpr float ATT_CUT = -48.0f;
constexpr int ATT_SCR = 2 * KBUFB + 3 * VBUFB;
template <int MODE>
__device__ __forceinline__ void attn_core(LAS unsigned char* lds, const bf16_t* Kh, const bf16_t* VTh, const bf16_t* qptr, int t, int j0, int j1, int jact,
                                          float sl, const unsigned short* mrow, float knb, f32x16 (&o)[4], float& m_out, float& l_out) {
    constexpr bool DESC = (MODE == 0);
    const int tid = opaque_tid(), lane = tid & 63, r32 = lane & 31, hi = lane >> 5, wid = __builtin_amdgcn_readfirstlane(tid >> 6);
    const bool lag = (MODE != 0) && wid >= 4;
    bf16x8 qr[8];
#pragma unroll
    for (int d0 = 0; d0 < 8; ++d0) qr[d0] = *(const bf16x8*)(qptr + 16 * d0 + 8 * hi);
    float rowb = 0.f;
    if (DESC) {
        float ss = 0.f;
#pragma unroll
        for (int d0 = 0; d0 < 8; ++d0)
#pragma unroll
            for (int e = 0; e < 8; ++e) { const float v = bf2f((unsigned short)qr[d0][e]); ss = fmaf(v, v, ss); }
        ss += __shfl_xor(ss, 32);
        rowb = sqrtf(ss) * knb;
    }
#pragma unroll
    for (int d0 = 0; d0 < 4; ++d0) o[d0] = f32x16{};
    float m = -1e30f, l = 0.f;
    const int nt = j1 - j0, jfirst = DESC ? j1 - 1 : j0;
    LAS unsigned char* Kr = lds; LAS unsigned char* Vr = lds + 2 * KBUFB;
    LAS int* donef = (LAS int*)(lds + ATT_SCR);
    bf16x8 sk0, sk1, sv0, sv1;
#define LOADKV(j_) do { const bf16_t* kp_ = Kh + (size_t)(64 * (j_) + (tid >> 3)) * HD + (tid & 7) * 8; sk0 = *(const bf16x8*)kp_; sk1 = *(const bf16x8*)(kp_ + 64); \
        const bf16_t* vp_ = VTh + (size_t)(tid >> 3) * SEQ + 64 * (j_) + (tid & 7) * 8; sv0 = *(const bf16x8*)vp_; sv1 = *(const bf16x8*)(vp_ + (size_t)64 * SEQ); } while (0)
#define WRITEKV(kb_, vb_) do { LAS unsigned char* kd_ = Kr + (kb_) * KBUFB + (tid >> 3) * KPITCH + (tid & 7) * 16; *(LAS bf16x8*)kd_ = sk0; *(LAS bf16x8*)(kd_ + 128) = sk1; \
        LAS unsigned char* vd_ = Vr + (vb_) * VBUFB + (tid >> 3) * VPITCH + (tid & 7) * 16; \
        *(LAS s16x4*)vd_ = __builtin_shufflevector(sv0, sv0, 0, 1, 2, 3); *(LAS s16x4*)(vd_ + 8) = __builtin_shufflevector(sv0, sv0, 4, 5, 6, 7); \
        *(LAS s16x4*)(vd_ + 64 * VPITCH) = __builtin_shufflevector(sv1, sv1, 0, 1, 2, 3); *(LAS s16x4*)(vd_ + 64 * VPITCH + 8) = __builtin_shufflevector(sv1, sv1, 4, 5, 6, 7); } while (0)
#define PVMM(vbuf_) do { const LAS unsigned char* vb_ = Vr + (vbuf_) * VBUFB + r32 * VPITCH + hi * 8; \
        _Pragma("unroll") for (int s = 0; s < 4; ++s) { \
            _Pragma("unroll") for (int d0 = 0; d0 < 4; ++d0) { const s16x4 vl_ = *(const LAS s16x4*)(vb_ + d0 * 32 * VPITCH + s * 32), vh_ = *(const LAS s16x4*)(vb_ + d0 * 32 * VPITCH + s * 32 + 16); \
                const bf16x8 a_ = (bf16x8){vl_[0], vl_[1], vl_[2], vl_[3], vh_[0], vh_[1], vh_[2], vh_[3]}; \
                o[d0] = __builtin_amdgcn_mfma_f32_32x32x16_bf16(a_, pb[s], o[d0], 0, 0, 0); } \
            __builtin_amdgcn_sched_barrier(0); } } while (0)
    LOADKV(jfirst); WRITEKV(0, 0);
    unsigned mb0 = 0xffffu, mb1 = 0xffffu;
    if (MODE == 0) { if (jfirst <= jact) { mb0 = mrow[(size_t)(2 * jfirst) * 64]; mb1 = mrow[(size_t)(2 * jfirst + 1) * 64]; } }
    bool wdone = false, pend = false;
    bf16x8 pb[4];
    int vcur = 0;
    __syncthreads();
    for (int it = 0; it < nt; ++it) {
        const int j = DESC ? j1 - 1 - it : j0 + it, jn = DESC ? j - 1 : j + 1;
        const int vprev = vcur == 0 ? 2 : vcur - 1, vnext = vcur == 2 ? 0 : vcur + 1;
        const bool more = it + 1 < nt;
        if (more) LOADKV(jn);
        unsigned nb0 = 0xffffu, nb1 = 0xffffu;
        if (MODE == 0) { if (more && jn <= jact && !wdone) { nb0 = mrow[(size_t)(2 * jn) * 64]; nb1 = mrow[(size_t)(2 * jn + 1) * 64]; } }
        if (pend) { PVMM(vprev); pend = false; }
        if (j <= jact && !wdone) {
            f32x16 s0, s1;
            const float base = (float)(64 * j - t + 4 * hi) * sl;
#pragma unroll
            for (int r = 0; r < 16; ++r) { const int c = (r & 3) + 8 * (r >> 2); s0[r] = fmaf(sl, (float)c, base); s1[r] = fmaf(sl, (float)(c + 32), base); }
            const LAS unsigned char* kb = Kr + (it & 1) * KBUFB + r32 * KPITCH + hi * 16;
#pragma unroll
            for (int g = 0; g < 2; ++g) {
                bf16x8 fa[4], fb[4];
#pragma unroll
                for (int d = 0; d < 4; ++d) { fa[d] = *(const LAS bf16x8*)(kb + (4 * g + d) * 32); fb[d] = *(const LAS bf16x8*)(kb + 32 * KPITCH + (4 * g + d) * 32); }
                __builtin_amdgcn_sched_barrier(0);
#pragma unroll
                for (int d = 0; d < 4; ++d) {
                    s0 = __builtin_amdgcn_mfma_f32_32x32x16_bf16(fa[d], qr[4 * g + d], s0, 0, 0, 0);
                    s1 = __builtin_amdgcn_mfma_f32_32x32x16_bf16(fb[d], qr[4 * g + d], s1, 0, 0, 0);
                }
                __builtin_amdgcn_sched_barrier(0);
            }
            if (MODE == 0) {
#pragma unroll
                for (int r = 0; r < 16; ++r) {
                    const unsigned u0 = (unsigned)__builtin_amdgcn_sbfe((int)mb0, r, 1), u1 = (unsigned)__builtin_amdgcn_sbfe((int)mb1, r, 1);
                    s0[r] = __uint_as_float((__float_as_uint(s0[r]) & u0) | (0xFF800000u & ~u0)); s1[r] = __uint_as_float((__float_as_uint(s1[r]) & u1) | (0xFF800000u & ~u1)); }
            }
            if (MODE == 2) {
                const int kp0 = 64 * j + 4 * hi;
#pragma unroll
                for (int r = 0; r < 16; ++r) { const int c = (r & 3) + 8 * (r >> 2); if (kp0 + c > t) s0[r] = NEG_INF; if (kp0 + c + 32 > t) s1[r] = NEG_INF; }
            }
            float tm = fmaxf(s0[0], s1[0]);
#pragma unroll
            for (int r = 1; r < 16; ++r) tm = fmaxf(tm, fmaxf(s0[r], s1[r]));
            tm = fmaxf(tm, __shfl_xor(tm, 32));
            const float mn = fmaxf(m, tm), alpha = fast_exp2((m - mn) * C2), mc = -mn * C2;
            m = mn;
            float ps = 0.f;
#pragma unroll
            for (int r = 0; r < 16; ++r) { s0[r] = fast_exp2(fmaf(s0[r], C2, mc)); s1[r] = fast_exp2(fmaf(s1[r], C2, mc)); ps += s0[r] + s1[r]; }
            ps += __shfl_xor(ps, 32);
            l = l * alpha + ps;
            if (__any(alpha != 1.0f)) {
#pragma unroll
                for (int d0 = 0; d0 < 4; ++d0)
#pragma unroll
                    for (int r = 0; r < 16; ++r) o[d0][r] *= alpha;
            }
            u32x4 pw;
            pw.x = cvt_pk_bf16(s0[0], s0[1]); pw.y = cvt_pk_bf16(s0[2], s0[3]); pw.z = cvt_pk_bf16(s0[4], s0[5]); pw.w = cvt_pk_bf16(s0[6], s0[7]); pb[0] = *(bf16x8*)&pw;
            pw.x = cvt_pk_bf16(s0[8], s0[9]); pw.y = cvt_pk_bf16(s0[10], s0[11]); pw.z = cvt_pk_bf16(s0[12], s0[13]); pw.w = cvt_pk_bf16(s0[14], s0[15]); pb[1] = *(bf16x8*)&pw;
            pw.x = cvt_pk_bf16(s1[0], s1[1]); pw.y = cvt_pk_bf16(s1[2], s1[3]); pw.z = cvt_pk_bf16(s1[4], s1[5]); pw.w = cvt_pk_bf16(s1[6], s1[7]); pb[2] = *(bf16x8*)&pw;
            pw.x = cvt_pk_bf16(s1[8], s1[9]); pw.y = cvt_pk_bf16(s1[10], s1[11]); pw.z = cvt_pk_bf16(s1[12], s1[13]); pw.w = cvt_pk_bf16(s1[14], s1[15]); pb[3] = *(bf16x8*)&pw;
            if (lag) pend = true; else PVMM(vcur);
            if (DESC) {
                const float xmax = rowb + sl * (float)(64 * j - 1 - t);
                wdone = __all(m > -1e29f && (xmax - m) * C2 < ATT_CUT) != 0;
            }
        }
        mb0 = nb0; mb1 = nb1;
        if (more) WRITEKV((it & 1) ^ 1, vnext);
        if (DESC) { if (lane == 0) donef[(it & 1) * 8 + wid] = wdone ? 1 : 0; }
        __syncthreads();
        vcur = vnext;
        if (DESC) { const LAS int* df = donef + (it & 1) * 8; if ((df[0] & df[1] & df[2] & df[3] & df[4] & df[5] & df[6] & df[7]) != 0) break; }
    }
    if (pend) { const int vprev = vcur == 0 ? 2 : vcur - 1; PVMM(vprev); }
    __syncthreads();
#undef LOADKV
#undef WRITEKV
#undef PVMM
    m_out = m; l_out = l;
}

constexpr int STG_OFF = ATT_SCR + 1024, STG_PITCH = 272, STG_WAVE = 32 * STG_PITCH, STG_END = STG_OFF + 8 * STG_WAVE;
static_assert(STG_END <= 158720, "lds");
#define STG_MEM() asm volatile("" ::: "memory")
__device__ __forceinline__ void stg_put_lines(LAS unsigned char* st, int lane, const u32x4 (&v)[8]) {
#pragma unroll
    for (int k = 0; k < 8; ++k) *(LAS u32x4*)(st + ((lane >> 3) + 8 * (k >> 1)) * STG_PITCH + 128 * (k & 1) + 16 * (lane & 7)) = v[k];
}
__device__ __forceinline__ void stg_get_lines(const LAS unsigned char* st, int lane, u32x4 (&v)[8]) {
#pragma unroll
    for (int k = 0; k < 8; ++k) v[k] = *(const LAS u32x4*)(st + ((lane >> 3) + 8 * (k >> 1)) * STG_PITCH + 128 * (k & 1) + 16 * (lane & 7));
}
__device__ __forceinline__ void stg_put_frag(LAS unsigned char* st, int r32, int hi, const u32x2 (&f)[16]) {
#pragma unroll
    for (int i = 0; i < 16; ++i) *(LAS u32x2*)(st + r32 * STG_PITCH + 64 * (i >> 2) + 16 * (i & 3) + 8 * hi) = f[i];
}
__device__ __forceinline__ void stg_get_frag(const LAS unsigned char* st, int r32, int hi, u32x2 (&f)[16]) {
#pragma unroll
    for (int i = 0; i < 16; ++i) f[i] = *(const LAS u32x2*)(st + r32 * STG_PITCH + 64 * (i >> 2) + 16 * (i & 3) + 8 * hi);
}
__device__ __forceinline__ void dsa_unit(LAS unsigned char* lds, int h, int qb, int j0, int j1, int slot, const bf16_t* Q, const bf16_t* K, const bf16_t* VT, const unsigned short* MASK, const bf16_t* SG, bf16_t* YG,
                                         bf16_t* PARTO, float* PARTML, float knb) {
    const int tid = opaque_tid(), wid = __builtin_amdgcn_readfirstlane(tid >> 6), lane = tid & 63, r32 = lane & 31, hi = lane >> 5;
    const int qt = 8 * qb + wid, t = 256 * qb + 32 * wid + r32;
    const float sl = exp2f(-(float)(h + 1)) / SCALE;
    f32x16 o[4]; float m, l;
    attn_core<0>(lds, K + (size_t)h * SEQ * HD, VT + (size_t)h * HD * SEQ, Q + ((size_t)h * SEQ + t) * HD, t, j0, j1, 4 * qb + (wid >> 1), sl,
                 MASK + ((size_t)qt * 512) * 64 + lane, knb, o, m, l);
    int te = t; asm volatile("" : "+v"(te));
    const float inv = l > 0.f ? 1.0f / l : 0.f;
    LAS unsigned char* st = lds + STG_OFF + wid * STG_WAVE;
    const int tw = 256 * qb + 32 * wid;
    if (slot < 0) {
        u32x4 ln[8];
#pragma unroll
        for (int k = 0; k < 8; ++k) ln[k] = *(const u32x4*)(SG + (size_t)(tw + (lane >> 3) + 8 * (k >> 1)) * DM + h * HD + 64 * (k & 1) + 8 * (lane & 7));
        stg_put_lines(st, lane, ln); STG_MEM();
        u32x2 f[16]; stg_get_frag(st, r32, hi, f); STG_MEM();
#pragma unroll
        for (int i = 0; i < 16; ++i) { const int d0 = i >> 2, r4 = i & 3; const u32x2 g = f[i];
            u32x2 w; w.x = cvt_pk_bf16(o[d0][4 * r4] * inv * bflo(g.x), o[d0][4 * r4 + 1] * inv * bfhi(g.x));
            w.y = cvt_pk_bf16(o[d0][4 * r4 + 2] * inv * bflo(g.y), o[d0][4 * r4 + 3] * inv * bfhi(g.y)); f[i] = w; }
        stg_put_frag(st, r32, hi, f); STG_MEM();
        stg_get_lines(st, lane, ln); STG_MEM();
#pragma unroll
        for (int k = 0; k < 8; ++k) *(u32x4*)(YG + (size_t)(tw + (lane >> 3) + 8 * (k >> 1)) * DM + h * HD + 64 * (k & 1) + 8 * (lane & 7)) = ln[k];
    } else {
        const size_t pw = (size_t)slot * 256 + 32 * wid;
        u32x2 f[16];
#pragma unroll
        for (int i = 0; i < 16; ++i) { const int d0 = i >> 2, r4 = i & 3;
            f[i].x = cvt_pk_bf16(o[d0][4 * r4] * inv, o[d0][4 * r4 + 1] * inv); f[i].y = cvt_pk_bf16(o[d0][4 * r4 + 2] * inv, o[d0][4 * r4 + 3] * inv); }
        stg_put_frag(st, r32, hi, f); STG_MEM();
        u32x4 ln[8]; stg_get_lines(st, lane, ln); STG_MEM();
#pragma unroll
        for (int k = 0; k < 8; ++k) *(u32x4*)(PARTO + (pw + (lane >> 3) + 8 * (k >> 1)) * HD + 64 * (k & 1) + 8 * (lane & 7)) = ln[k];
        if (hi == 0) *(f32x2*)(PARTML + (pw + r32) * 2) = (f32x2){m, l};
    }
}
__device__ __forceinline__ void dsa_merge(int bid, int G, int tid, const bf16_t* PARTO, const float* PARTML, const bf16_t* SG, bf16_t* YG) {
    for (int idx = bid * 512 + tid; idx < 48 * 256 * 16; idx += G * 512) {
        const int k = idx >> 12, row = (idx >> 4) & 255, dc = idx & 15;
        const int qb = 63 - k, t = 256 * qb + row, nch = (4 * qb + 4 + 63) >> 6;
        float pm[4], pl[4]; float M = -1e30f;
#pragma unroll
        for (int c = 0; c < 4; ++c) { pm[c] = -1e30f; pl[c] = 0.f; if (c < nch) { const f32x2 v = *(const f32x2*)(PARTML + ((size_t)(4 * k + c) * 256 + row) * 2); pm[c] = v[0]; pl[c] = v[1]; M = fmaxf(M, pm[c]); } }
        float acc[8] = {0.f, 0.f, 0.f, 0.f, 0.f, 0.f, 0.f, 0.f}; float den = 0.f;
#pragma unroll
        for (int c = 0; c < 4; ++c) if (c < nch && pl[c] > 0.f) {
            const float w = pl[c] * fast_exp2((pm[c] - M) * C2); den += w;
            const u32x4 x = *(const u32x4*)(PARTO + ((size_t)(4 * k + c) * 256 + row) * HD + dc * 8);
            acc[0] = fmaf(w, bflo(x.x), acc[0]); acc[1] = fmaf(w, bfhi(x.x), acc[1]); acc[2] = fmaf(w, bflo(x.y), acc[2]); acc[3] = fmaf(w, bfhi(x.y), acc[3]);
            acc[4] = fmaf(w, bflo(x.z), acc[4]); acc[5] = fmaf(w, bfhi(x.z), acc[5]); acc[6] = fmaf(w, bflo(x.w), acc[6]); acc[7] = fmaf(w, bfhi(x.w), acc[7]);
        }
        const float inv = 1.0f / den;
        const size_t off = (size_t)t * DM + 7 * HD + dc * 8;
        const u32x4 g = *(const u32x4*)(SG + off);
        u32x4 r;
        r.x = cvt_pk_bf16(acc[0] * inv * bflo(g.x), acc[1] * inv * bfhi(g.x)); r.y = cvt_pk_bf16(acc[2] * inv * bflo(g.y), acc[3] * inv * bfhi(g.y));
        r.z = cvt_pk_bf16(acc[4] * inv * bflo(g.z), acc[5] * inv * bfhi(g.z)); r.w = cvt_pk_bf16(acc[6] * inv * bflo(g.w), acc[7] * inv * bfhi(g.w));
        *(u32x4*)(YG + off) = r;
    }
}
__device__ __forceinline__ void moba_sel_unit(LAS unsigned char* lds, int h, int b, int c, int cnt, const unsigned* LIST, const bf16_t* Q, const bf16_t* K, const bf16_t* VT, bf16_t* PARTO, float* PARTML) {
    const int tid = opaque_tid(), wid = __builtin_amdgcn_readfirstlane(tid >> 6), lane = tid & 63, r32 = lane & 31, hi = lane >> 5;
    const int i = 256 * c + 32 * wid + r32; const bool valid = i < cnt;
    const unsigned e = LIST[((size_t)h * 64 + b) * SEQ + (valid ? i : cnt - 1)];
    const int t = (int)(e >> 2), rank = (int)(e & 3u);
    const float sl = exp2f(-(float)(h + 1)) / SCALE;
    f32x16 o[4]; float m, l;
    attn_core<1>(lds, K + (size_t)h * SEQ * HD, VT + (size_t)h * HD * SEQ, Q + ((size_t)h * SEQ + t) * HD, t, 4 * b, 4 * b + 4, (256 * c + 32 * wid < cnt) ? 4 * b + 3 : -1, sl, nullptr, 0.f, o, m, l);
    int te = t; asm volatile("" : "+v"(te));
    {
        const float inv = 1.0f / l; const unsigned pr = (unsigned)(((size_t)h * SEQ + te) * 3 + rank);
        LAS unsigned char* st = lds + STG_OFF + wid * STG_WAVE;
        u32x2 f[16];
#pragma unroll
        for (int i = 0; i < 16; ++i) { const int d0 = i >> 2, r4 = i & 3;
            f[i].x = cvt_pk_bf16(o[d0][4 * r4] * inv, o[d0][4 * r4 + 1] * inv); f[i].y = cvt_pk_bf16(o[d0][4 * r4 + 2] * inv, o[d0][4 * r4 + 3] * inv); }
        stg_put_frag(st, r32, hi, f);
        if (hi == 0) *(LAS unsigned*)(st + r32 * STG_PITCH + 256) = valid ? pr : 0xffffffffu;
        STG_MEM();
        u32x4 ln[8]; stg_get_lines(st, lane, ln);
        unsigned prow[4];
#pragma unroll
        for (int i = 0; i < 4; ++i) prow[i] = *(const LAS unsigned*)(st + ((lane >> 3) + 8 * i) * STG_PITCH + 256);
        STG_MEM();
#pragma unroll
        for (int k = 0; k < 8; ++k) if (prow[k >> 1] != 0xffffffffu) *(u32x4*)(PARTO + (size_t)prow[k >> 1] * HD + 64 * (k & 1) + 8 * (lane & 7)) = ln[k];
        if (valid && hi == 0) *(f32x2*)(PARTML + (size_t)pr * 2) = (f32x2){m, l};
    }
}
__device__ __forceinline__ void moba_own_unit(LAS unsigned char* lds, int h, int b, const bf16_t* Q, const bf16_t* K, const bf16_t* VT, const bf16_t* PARTO, const float* PARTML, const bf16_t* SG, bf16_t* YG) {
    const int tid = opaque_tid(), wid = __builtin_amdgcn_readfirstlane(tid >> 6), lane = tid & 63, r32 = lane & 31, hi = lane >> 5;
    const int t = 256 * b + 32 * wid + r32;
    const float sl = exp2f(-(float)(h + 1)) / SCALE;
    f32x16 o[4]; float m, l;
    attn_core<2>(lds, K + (size_t)h * SEQ * HD, VT + (size_t)h * HD * SEQ, Q + ((size_t)h * SEQ + t) * HD, t, 4 * b, 4 * b + 4, 4 * b + (wid >> 1), sl, nullptr, 0.f, o, m, l);
    int te = t; asm volatile("" : "+v"(te));
    const int nv = b < 3 ? b : 3; const size_t pr = ((size_t)h * SEQ + te) * 3;
    float pm[3], pl[3]; float M = m;
#pragma unroll
    for (int r = 0; r < 3; ++r) { pm[r] = -1e30f; pl[r] = 0.f; if (r < nv) { const f32x2 v = *(const f32x2*)(PARTML + (pr + r) * 2); pm[r] = v[0]; pl[r] = v[1]; M = fmaxf(M, pm[r]); } }
    const float wo = fast_exp2((m - M) * C2);
    float wr_[3]; float den = l * wo;
#pragma unroll
    for (int r = 0; r < 3; ++r) { wr_[r] = (r < nv) ? pl[r] * fast_exp2((pm[r] - M) * C2) : 0.f; den += wr_[r]; }
    const float inv = 1.0f / den;
    LAS unsigned char* st = lds + STG_OFF + wid * STG_WAVE;
    const int tw = 256 * b + 32 * wid;
    u32x4 lp[3][8], lg[8];
#pragma unroll
    for (int r = 0; r < 3; ++r) if (r < nv) {
#pragma unroll
        for (int k = 0; k < 8; ++k) lp[r][k] = *(const u32x4*)(PARTO + (((size_t)h * SEQ + tw + (lane >> 3) + 8 * (k >> 1)) * 3 + r) * HD + 64 * (k & 1) + 8 * (lane & 7));
    }
#pragma unroll
    for (int k = 0; k < 8; ++k) lg[k] = *(const u32x4*)(SG + (size_t)(tw + (lane >> 3) + 8 * (k >> 1)) * DM + HALFW + h * HD + 64 * (k & 1) + 8 * (lane & 7));
#pragma unroll
    for (int d0 = 0; d0 < 4; ++d0)
#pragma unroll
        for (int i = 0; i < 16; ++i) o[d0][i] *= wo;
    u32x2 f[16];
#pragma unroll
    for (int r = 0; r < 3; ++r) if (r < nv) {
        stg_put_lines(st, lane, lp[r]); STG_MEM();
        stg_get_frag(st, r32, hi, f); STG_MEM();
        const bool use = pl[r] > 0.f;
#pragma unroll
        for (int i = 0; i < 16; ++i) { const int d0 = i >> 2, r4 = i & 3; const u32x2 p = use ? f[i] : (u32x2){0u, 0u};
            o[d0][4 * r4] = fmaf(wr_[r], bflo(p.x), o[d0][4 * r4]); o[d0][4 * r4 + 1] = fmaf(wr_[r], bfhi(p.x), o[d0][4 * r4 + 1]);
            o[d0][4 * r4 + 2] = fmaf(wr_[r], bflo(p.y), o[d0][4 * r4 + 2]); o[d0][4 * r4 + 3] = fmaf(wr_[r], bfhi(p.y), o[d0][4 * r4 + 3]); }
    }
    stg_put_lines(st, lane, lg); STG_MEM();
    stg_get_frag(st, r32, hi, f); STG_MEM();
#pragma unroll
    for (int i = 0; i < 16; ++i) { const int d0 = i >> 2, r4 = i & 3; const u32x2 g = f[i];
        u32x2 w; w.x = cvt_pk_bf16(o[d0][4 * r4] * inv * bflo(g.x), o[d0][4 * r4 + 1] * inv * bfhi(g.x)); w.y = cvt_pk_bf16(o[d0][4 * r4 + 2] * inv * bflo(g.y), o[d0][4 * r4 + 3] * inv * bfhi(g.y)); f[i] = w; }
    stg_put_frag(st, r32, hi, f); STG_MEM();
    stg_get_lines(st, lane, lg); STG_MEM();
#pragma unroll
    for (int k = 0; k < 8; ++k) *(u32x4*)(YG + (size_t)(tw + (lane >> 3) + 8 * (k >> 1)) * DM + HALFW + h * HD + 64 * (k & 1) + 8 * (lane & 7)) = lg[k];
}
}

namespace dsa {
constexpr int NB = 512, CAP = 256;
constexpr int QPITCH = 1296;
constexpr int HSTR = 513;
__device__ __forceinline__ void fold_abs(f32x16& sc, const f32x16& a, float w) {
#pragma unroll
    for (int r = 0; r < 16; ++r) { float t = fmaf(w, __builtin_fabsf(a[r]), sc[r]); asm volatile("" : "+v"(t)); sc[r] = t; }
}
__device__ __forceinline__ void scores2(f32x16& sc0, f32x16& sc1, const bf16x8 (&ka)[4], const bf16x8 (&kb)[4], const LAS unsigned char* qrow, const float (&w)[8]) {
    bf16x8 b0[4], b1[4];
#define DSA_LDB(dst, off) do { _Pragma("unroll") for (int s_ = 0; s_ < 4; ++s_) dst[s_] = *(const LAS bf16x8*)(qrow + ((off) + 16 * s_) * 2); } while (0)
#define DSA_MM(c0, c1, bb) do { __builtin_amdgcn_s_setprio(1); _Pragma("unroll") for (int s_ = 0; s_ < 4; ++s_) { c0 = __builtin_amdgcn_mfma_f32_32x32x16_bf16(ka[s_], bb[s_], c0, 0, 0, 0); c1 = __builtin_amdgcn_mfma_f32_32x32x16_bf16(kb[s_], bb[s_], c1, 0, 0, 0); } __builtin_amdgcn_s_setprio(0); } while (0)
#define DSA_SB __builtin_amdgcn_sched_barrier(0)
    sc0 = f32x16{}; sc1 = f32x16{};
    DSA_LDB(b0, 512); DSA_LDB(b1, 0); DSA_SB;
    DSA_MM(sc0, sc1, b0); DSA_SB;
#define DSA_HEAD(h, cur, nxt) do { f32x16 a0 = {}, a1 = {}; if ((h) < 7) DSA_LDB(nxt, 64 * ((h) + 1)); DSA_SB; DSA_MM(a0, a1, cur); fold_abs(sc0, a0, w[h]); fold_abs(sc1, a1, w[h]); DSA_SB; } while (0)
    DSA_HEAD(0, b1, b0); DSA_HEAD(1, b0, b1); DSA_HEAD(2, b1, b0); DSA_HEAD(3, b0, b1); DSA_HEAD(4, b1, b0); DSA_HEAD(5, b0, b1); DSA_HEAD(6, b1, b0); DSA_HEAD(7, b0, b1);
#undef DSA_HEAD
#undef DSA_SB
#undef DSA_MM
#undef DSA_LDB
}
__device__ __forceinline__ void load_ka(bf16x8 (&ka)[4], const bf16_t* KI, int kt, int r32, int hi) {
    const bf16_t* kp = KI + (size_t)(32 * kt + r32) * 64 + 8 * hi;
#pragma unroll
    for (int s = 0; s < 4; ++s) ka[s] = *(const bf16x8*)(kp + 16 * s);
}
__device__ __forceinline__ int bin0f(float sc, int kofs) {
    const int b = __float_as_int(sc), kk = (b >> 19) & 0xFFF; int p = kk + kofs; p = p < 256 ? 256 : (p > NB - 1 ? NB - 1 : p); return p ^ ((b >> 31) & (NB - 1)); }
__device__ __forceinline__ int binf(float sc, float lo, float inv) { int b = (int)fmaf(sc, inv, -lo * inv); return b < 0 ? 0 : (b > NB - 1 ? NB - 1 : b); }
__device__ __forceinline__ void select_unit(LAS unsigned char* lds, int qt, const bf16_t* QI, const float* WI, const bf16_t* KI, float kib, unsigned short* MASK) {
    const int tid = opaque_tid(), wid = __builtin_amdgcn_readfirstlane(tid >> 6), lane = tid & 63, r32 = lane & 31, hi = lane >> 5;
    LAS unsigned* hist = (LAS unsigned*)lds;
    LAS float* cs = (LAS float*)lds; LAS unsigned short* ck = (LAS unsigned short*)(lds + 32768);
    LAS unsigned short* bits16 = (LAS unsigned short*)(lds + 49152); LAS unsigned* bits32 = (LAS unsigned*)(lds + 49152);
    LAS int* Tq = (LAS int*)(lds + 114688);
    LAS float* loq = (LAS float*)(Tq + 96);
    LAS float* invq = loq + 96;
    LAS int* abv = (LAS int*)(invq + 96);
    LAS int* needv = abv + 32; LAS int* donev = needv + 32; LAS int* Lq = donev + 32; LAS unsigned* ccnt = (LAS unsigned*)(Lq + 32); LAS int* KBq = (LAS int*)(ccnt + 32); LAS int* mode1 = KBq + 32; LAS int* flag = mode1 + 32;
    const int t = 32 * qt + r32;
    LAS unsigned char* qlds = lds + 117760;
    { const int row = tid >> 4, ch = tid & 15;
      bf16x8 qv[4];
#pragma unroll
      for (int i = 0; i < 4; ++i) qv[i] = *(const bf16x8*)(QI + (size_t)(32 * qt + row) * 512 + (ch * 4 + i) * 8);
      __builtin_amdgcn_sched_barrier(0);
#pragma unroll
      for (int i = 0; i < 4; ++i) *(LAS bf16x8*)(qlds + row * QPITCH + (ch * 4 + i) * 16) = qv[i]; }
    __syncthreads();
    const LAS unsigned char* qrow = qlds + r32 * QPITCH + hi * 16;
    float w[8];
    float bsum = 0.f;
    const f32x4 wia = *(const f32x4*)(WI + (size_t)t * 8), wib = *(const f32x4*)(WI + (size_t)t * 8 + 4);
#pragma unroll
    for (int h = 0; h < 8; ++h) {
        float ss = 0.f;
#pragma unroll
        for (int s = 0; s < 4; ++s) { const bf16x8 q8 = *(const LAS bf16x8*)(qrow + (64 * h + 16 * s) * 2);
#pragma unroll
            for (int e = 0; e < 8; ++e) { const float v = bf2f((unsigned short)q8[e]); ss = fmaf(v, v, ss); } }
        ss += __shfl_xor(ss, 32);
        w[h] = (h < 4 ? wia[h & 3] : wib[h & 3]) * 0.0625f;
        bsum += fabsf(w[h]) * sqrtf(ss);
    }
    bsum *= 2.0f;
    {
        const int q = tid >> 4, d0 = (tid & 15) * 4;
        float wq[8];
        { const f32x4 qa = *(const f32x4*)(WI + (size_t)(32 * qt + q) * 8), qb = *(const f32x4*)(WI + (size_t)(32 * qt + q) * 8 + 4);
#pragma unroll
          for (int h = 0; h < 8; ++h) wq[h] = (h < 4 ? qa[h & 3] : qb[h & 3]) * 0.0625f; }
        float c4[4] = {0.f, 0.f, 0.f, 0.f};
#pragma unroll
        for (int h = 0; h < 8; ++h) { const u32x2 v = *(const LAS u32x2*)(qlds + q * QPITCH + (64 * h + d0) * 2);
            c4[0] = fmaf(wq[h], bflo(v.x), c4[0]); c4[1] = fmaf(wq[h], bfhi(v.x), c4[1]); c4[2] = fmaf(wq[h], bflo(v.y), c4[2]); c4[3] = fmaf(wq[h], bfhi(v.y), c4[3]); }
        u32x2 hh, ll; hh.x = cvt_pk_bf16(c4[0], c4[1]); hh.y = cvt_pk_bf16(c4[2], c4[3]);
        ll.x = cvt_pk_bf16(c4[0] - bflo(hh.x), c4[1] - bfhi(hh.x)); ll.y = cvt_pk_bf16(c4[2] - bflo(hh.y), c4[3] - bfhi(hh.y));
        *(LAS u32x2*)(qlds + q * QPITCH + (512 + d0) * 2) = hh; *(LAS u32x2*)(qlds + q * QPITCH + (576 + d0) * 2) = ll;
    }
#define BSCALE 1.0f
    { const float Bt = (bsum * kib * 1.02f + 1e-30f) * BSCALE;
      if (wid == 0 && hi == 0) { KBq[r32] = (__float_as_int(Bt) >> 19) + 1; mode1[r32] = 0; loq[r32] = 0.f; invq[r32] = 0.f; abv[r32] = 0; donev[r32] = 0; Lq[r32] = 0; Tq[r32] = -1; needv[r32] = 0; }
      if (tid < 3) flag[tid] = 0; }
    __syncthreads();
    for (int lvl = 0; lvl < 3; ++lvl) {
        for (int i = tid; i < 32 * HSTR; i += 512) hist[i] = 0u;
        __syncthreads();
        const float lo1 = loq[32 + r32], in1 = invq[32 + r32], lo2 = loq[64 + r32], in2 = invq[64 + r32];
        const int T0 = Tq[r32], T1 = Tq[32 + r32], mydone = donev[r32], kbq_ = KBq[r32], kofs = 512 - kbq_;
#define REPA 0
        int dummy_ = 0;
        for (int repa = 0; repa <= REPA; ++repa) {
        const unsigned addv = repa == 0 ? 1u : 0u;
        bf16x8 ka[4], kb[4], kn[4], knb[4];
        if (2 * wid <= qt) { load_ka(ka, KI, 2 * wid, r32, hi); load_ka(kb, KI, 2 * wid + 1, r32, hi); }
        for (int kt = 2 * wid; kt <= qt; kt += 16) {
            asm volatile("" : "+v"(ka[0]), "+v"(ka[1]), "+v"(ka[2]), "+v"(ka[3]), "+v"(kb[0]), "+v"(kb[1]), "+v"(kb[2]), "+v"(kb[3]));
            if (kt + 16 <= qt) { load_ka(kn, KI, kt + 16, r32, hi); load_ka(knb, KI, kt + 17, r32, hi); }
            f32x16 sc0, sc1;
            scores2(sc0, sc1, ka, kb, qrow, w);
#pragma unroll
            for (int s = 0; s < 4; ++s) { ka[s] = kn[s]; kb[s] = knb[s]; }
            if (lvl == 0 && kt + 1 < qt) {
                {
#pragma unroll
                for (int r = 0; r < 16; ++r) { const int bin = bin0f(sc0[r], kofs); __hip_atomic_fetch_add(hist + r32 * HSTR + bin, addv, __ATOMIC_RELAXED, __HIP_MEMORY_SCOPE_WORKGROUP); }
#pragma unroll
                for (int r = 0; r < 16; ++r) { const int bin = bin0f(sc1[r], kofs); __hip_atomic_fetch_add(hist + r32 * HSTR + bin, addv, __ATOMIC_RELAXED, __HIP_MEMORY_SCOPE_WORKGROUP); }
                }
            } else {
#pragma unroll
                for (int half = 0; half < 2; ++half)
#pragma unroll
                for (int r = 0; r < 16; ++r) {
                    const float v = half ? sc1[r] : sc0[r];
                    const int kp = 32 * (kt + half) + crow(r, hi);
                    bool mem = (kp <= t) && (mydone == 0);
                    const int b0 = bin0f(v, kofs), b1 = binf(v, lo1, in1);
                    if (lvl > 0) mem = mem && (b0 == T0);
                    if (lvl > 1) mem = mem && (b1 == T1);
                    if (mem) { const int bin = lvl == 0 ? b0 : (lvl == 1 ? b1 : binf(v, lo2, in2)); __hip_atomic_fetch_add(hist + r32 * HSTR + bin, addv, __ATOMIC_RELAXED, __HIP_MEMORY_SCOPE_WORKGROUP); }
                }
            }
        }
        }
        if (dummy_ == 0x7fffffff) hist[0] = 1u;
        __syncthreads();
        for (int qq = 0; qq < 4; ++qq) {
            const int q = 4 * wid + qq;
            if (donev[q] != 0) continue;
            const unsigned target = (unsigned)(256 - abv[q]);
            unsigned c[8]; unsigned tot = 0;
#pragma unroll
            for (int i = 0; i < 8; ++i) { c[i] = hist[q * HSTR + 8 * lane + i]; tot += c[i]; }
            unsigned suf = tot;
#pragma unroll
            for (int off = 1; off < 64; off <<= 1) { const unsigned v = __shfl_down(suf, off); if (lane + off < 64) suf += v; }
            const unsigned long long bal = __ballot(suf >= target);
            if (bal == 0ull) { if (lane == 0) { Tq[lvl * 32 + q] = -1; needv[q] = 0; donev[q] = 1; Lq[q] = lvl; } }
            else {
                const int Lc = 63 - __builtin_clzll(bal);
                if (lane == Lc) {
                    unsigned above = suf - tot; int T = 8 * lane; int nd = 0; unsigned cand = 0;
#pragma unroll
                    for (int b = 7; b >= 0; --b) { if (nd == 0) { if (above + c[b] >= target) { T = 8 * lane + b; nd = (int)(target - above); cand = c[b]; } else above += c[b]; } }
                    Tq[lvl * 32 + q] = T; needv[q] = nd; abv[q] = 256 - nd;
                    if (cand <= (unsigned)CAP || lvl == 2) { donev[q] = 1; Lq[q] = lvl; }
                    else { const int kbq = KBq[q];
                           if (lvl == 0) { float e0, e1; const int kbp = kbq - 256;
                               if (T >= 256) { const int kk = T - 256 + kbp; e0 = (T == 256) ? 0.f : __int_as_float(kk << 19); e1 = __int_as_float((kk + 1) << 19); }
                               else { const int kk = 255 - T + kbp; e0 = -__int_as_float((kk + 1) << 19); e1 = (T == 255) ? 0.f : -__int_as_float(kk << 19); }
                               loq[32 + q] = e0; invq[32 + q] = (float)NB / (e1 - e0);
                           } else { const float lo = loq[32 + q], in = invq[32 + q]; loq[64 + q] = lo + (float)T / in; invq[64 + q] = in * (float)NB; }
                           flag[lvl] = 1; }
                }
            }
        }
        __syncthreads();
        if (flag[lvl] == 0) break;
    }
    if (tid < 32) ccnt[tid] = 0u;
    __syncthreads();
    {
        const float lo1 = loq[32 + r32], in1 = invq[32 + r32], lo2 = loq[64 + r32], in2 = invq[64 + r32];
        const int T0 = Tq[r32], T1 = Tq[32 + r32], T2 = Tq[64 + r32], L = Lq[r32], kbq_ = KBq[r32], kofs = 512 - kbq_;
        const bool fast = (flag[0] == 0);
        float thA, thB; bool centre = (T0 == 255 || T0 == 256);
        if (T0 < 0) { thA = NEG_INF; thB = NEG_INF; }
        else if (T0 >= 257) { thA = (T0 == 511) ? __builtin_inff() : __int_as_float((T0 + 1 - kofs) << 19); thB = __int_as_float((T0 - kofs) << 19); }
        else { const unsigned M1 = (unsigned)(511 - T0 - kofs) << 19;
               thA = __uint_as_float((0x80000000u | M1) - 1u); thB = (T0 == 0) ? __uint_as_float(0xFF7FFFFFu) : __uint_as_float((0x80000000u | (M1 + (1u << 19))) - 1u); }
        { const int kkE = T0 >= 257 ? T0 - kofs : 511 - T0 - kofs; if (T0 >= 0 && (kkE < 1 || kkE > 4078)) centre = true; }
        const bool fast2 = fast && !__any(centre);
        bf16x8 ka[4], kb[4], kn[4], knb[4];
        if (2 * wid <= qt) { load_ka(ka, KI, 2 * wid, r32, hi); load_ka(kb, KI, 2 * wid + 1, r32, hi); }
        for (int kt = 2 * wid; kt <= qt; kt += 16) {
            asm volatile("" : "+v"(ka[0]), "+v"(ka[1]), "+v"(ka[2]), "+v"(ka[3]), "+v"(kb[0]), "+v"(kb[1]), "+v"(kb[2]), "+v"(kb[3]));
            if (kt + 16 <= qt) { load_ka(kn, KI, kt + 16, r32, hi); load_ka(knb, KI, kt + 17, r32, hi); }
            f32x16 sc0, sc1;
            scores2(sc0, sc1, ka, kb, qrow, w);
#pragma unroll
            for (int s = 0; s < 4; ++s) { ka[s] = kn[s]; kb[s] = knb[s]; }
            unsigned bits0 = 0u, bits1 = 0u;
            if (fast2 && kt + 1 < qt) {
#pragma unroll
                for (int half = 0; half < 2; ++half) {
                    unsigned bv = 0u;
#pragma unroll
                    for (int r = 15; r >= 0; --r) {
                        const float v = half ? sc1[r] : sc0[r];
                        asm volatile("v_cmp_ge_f32_e32 vcc, %1, %2\n\ts_nop 1\n\tv_addc_co_u32_e32 %0, vcc, %0, %0, vcc" : "+v"(bv) : "v"(v), "v"(thA) : "vcc");
                        if (v >= thB && v < thA) { const unsigned s = __hip_atomic_fetch_add(ccnt + r32, 1u, __ATOMIC_RELAXED, __HIP_MEMORY_SCOPE_WORKGROUP); if (s < (unsigned)CAP) { cs[r32 * CAP + s] = v; ck[r32 * CAP + s] = (unsigned short)(32 * (kt + half) + crow(r, hi)); } }
                    }
                    if (half) bits1 = bv; else bits0 = bv;
                }
            } else if (fast && kt + 1 < qt) {
#pragma unroll
                for (int half = 0; half < 2; ++half)
#pragma unroll
                for (int r = 0; r < 16; ++r) {
                    const float v = half ? sc1[r] : sc0[r];
                    const int b0 = bin0f(v, kofs);
                    if (half) bits1 |= (b0 > T0) ? (1u << r) : 0u; else bits0 |= (b0 > T0) ? (1u << r) : 0u;
                    if (b0 == T0) { const unsigned s = __hip_atomic_fetch_add(ccnt + r32, 1u, __ATOMIC_RELAXED, __HIP_MEMORY_SCOPE_WORKGROUP); if (s < (unsigned)CAP) { cs[r32 * CAP + s] = v; ck[r32 * CAP + s] = (unsigned short)(32 * (kt + half) + crow(r, hi)); } }
                }
            } else {
#pragma unroll
                for (int half = 0; half < 2; ++half)
#pragma unroll
                for (int r = 0; r < 16; ++r) {
                    const float v = half ? sc1[r] : sc0[r];
                    const int kp = 32 * (kt + half) + crow(r, hi);
                    if (kp <= t) {
                        const int b0 = bin0f(v, kofs);
                        bool sel = b0 > T0, cand = (b0 == T0);
                        if (cand && L > 0) { const int b1 = binf(v, lo1, in1); sel = b1 > T1; cand = (b1 == T1);
                            if (cand && L > 1) { const int b2 = binf(v, lo2, in2); sel = b2 > T2; cand = (b2 == T2); } }
                        if (sel) { if (half) bits1 |= 1u << r; else bits0 |= 1u << r; }
                        else if (cand) { const unsigned s = __hip_atomic_fetch_add(ccnt + r32, 1u, __ATOMIC_RELAXED, __HIP_MEMORY_SCOPE_WORKGROUP); if (s < (unsigned)CAP) { cs[r32 * CAP + s] = v; ck[r32 * CAP + s] = (unsigned short)kp; } }
                    }
                }
            }
            bits16[kt * 64 + lane] = (unsigned short)bits0;
            bits16[(kt + 1) * 64 + lane] = (unsigned short)bits1;
        }
    }
    __syncthreads();
#ifndef REPR
#define REPR 0
#endif
    for (int repr = 0; repr <= REPR; ++repr)
    for (int qq = 0; qq < 4; ++qq) {
        const int q = 4 * wid + qq; const int nd = needv[q]; unsigned n = ccnt[q]; n = n > (unsigned)CAP ? (unsigned)CAP : n;
        if (nd <= 0 || n == 0u) continue;
        unsigned key[4], kk[4]; bool val[4];
#pragma unroll
        for (int e = 0; e < 4; ++e) { const unsigned i = lane + 64 * e; val[e] = i < n; const unsigned u = val[e] ? __float_as_uint(cs[q * CAP + i]) : 0u; key[e] = (u & 0x80000000u) ? ~u : (u | 0x80000000u); kk[e] = val[e] ? (unsigned)ck[q * CAP + i] : 0xffffffffu; if (!val[e]) key[e] = 0u; }
        unsigned x = 0u;
        for (int bit = 31; bit >= 0; --bit) {
            const unsigned trial = x | (1u << bit); int c = 0;
#pragma unroll
            for (int e = 0; e < 4; ++e) c += __popcll(__ballot(val[e] && key[e] >= trial));
            if (c >= nd) x = trial;
        }
        int cgt = 0;
#pragma unroll
        for (int e = 0; e < 4; ++e) cgt += __popcll(__ballot(val[e] && key[e] > x));
        int ties = nd - cgt;
        bool sel[4];
#pragma unroll
        for (int e = 0; e < 4; ++e) sel[e] = val[e] && key[e] > x;
        unsigned last = 0u; bool first = true;
        for (int it = 0; it < ties; ++it) {
            unsigned best = 0xffffffffu;
#pragma unroll
            for (int e = 0; e < 4; ++e) { const bool ok = val[e] && key[e] == x && (first || kk[e] > last); best = ok && kk[e] < best ? kk[e] : best; }
#pragma unroll
            for (int o = 1; o < 64; o <<= 1) { const unsigned v = __shfl_xor(best, o); best = v < best ? v : best; }
            if (best == 0xffffffffu) break;
#pragma unroll
            for (int e = 0; e < 4; ++e) sel[e] = sel[e] || (val[e] && key[e] == x && kk[e] == best);
            last = best; first = false;
        }
#pragma unroll
        for (int e = 0; e < 4; ++e) if (sel[e]) {
            const unsigned ki = kk[e];
            const int kt = (int)(ki >> 5), cc = (int)(ki & 31u), hh = (cc >> 2) & 1, rr = (cc & 3) + 4 * (cc >> 3);
            const int idx = kt * 64 + hh * 32 + q;
            __hip_atomic_fetch_or(bits32 + (idx >> 1), 1u << (16 * (idx & 1) + rr), __ATOMIC_RELAXED, __HIP_MEMORY_SCOPE_WORKGROUP);
        }
    }
    __syncthreads();
    { const int nw = (qt + 1 + ((qt & 1) == 0 ? 1 : 0)) * 32; unsigned* mw = (unsigned*)MASK + (size_t)qt * 512 * 32;
      for (int i = tid; i < nw; i += 512) mw[i] = bits32[i]; }
    __syncthreads();
}
}

__device__ __forceinline__ void conv_unit(LAS unsigned char* lds, int tile, const bf16_t* U, const float* cw, const float* cb, const float* lg, const float* lb, const bf16_t* SG, bf16_t* YG) {
    const int tid = opaque_tid(), wid = __builtin_amdgcn_readfirstlane(tid >> 6), lane = tid & 63;
    const int t0 = 32 * tile, c0 = 2 * tid;
    float w0[31], w1[31];
#pragma unroll
    for (int j = 0; j < 31; ++j) { const f32x2 v = *(const f32x2*)(cw + j * HALFW + c0); w0[j] = v[0]; w1[j] = v[1]; }
    float y0[32], y1[32];
    { const f32x2 b = *(const f32x2*)(cb + c0);
#pragma unroll
      for (int i = 0; i < 32; ++i) { y0[i] = b[0]; y1[i] = b[1]; } }
#define CONV_LD(dst, base_i) do { _Pragma("unroll") for (int i_ = 0; i_ < 16; ++i_) { const int ti = t0 - 30 + (base_i) + i_; const unsigned v_ = *(const unsigned*)(U + (size_t)(ti < 0 ? 0 : (ti > SEQ - 1 ? SEQ - 1 : ti)) * HALFW + c0); dst[i_] = (ti < 0 || (base_i) + i_ >= 62) ? 0u : v_; } } while (0)
#define CONV_AP(src, base_i) do { _Pragma("unroll") for (int i_ = 0; i_ < 16; ++i_) { const float u0 = bflo(src[i_]), u1 = bfhi(src[i_]); \
        _Pragma("unroll") for (int j = 0; j < 31; ++j) { const int tt = (base_i) + i_ - j; if ((base_i) + i_ < 62 && tt >= 0 && tt < 32) { y0[tt] = fmaf(w0[j], u0, y0[tt]); y1[tt] = fmaf(w1[j], u1, y1[tt]); } } } } while (0)
    { unsigned ua[16], ub[16];
      CONV_LD(ua, 0); CONV_LD(ub, 16); CONV_AP(ua, 0); CONV_LD(ua, 32); CONV_AP(ub, 16); CONV_LD(ub, 48); CONV_AP(ua, 32); CONV_AP(ub, 48); }
#undef CONV_LD
#undef CONV_AP
    float v[64];
#pragma unroll
    for (int i = 0; i < 32; ++i) { v[i] = y0[i] + y1[i]; v[32 + i] = y0[i] * y0[i] + y1[i] * y1[i]; }
#pragma unroll
    for (int k = 32; k >= 1; k >>= 1) {
        const bool up = (lane & k) != 0;
#pragma unroll
        for (int i = 0; i < k; ++i) { const float keep = up ? v[k + i] : v[i], give = up ? v[i] : v[k + i]; v[i] = keep + __shfl_xor(give, k); }
    }
    LAS float* part = (LAS float*)(lds + SCR_OFF);
    LAS float* stat = part + 512;
    __syncthreads();
    part[wid * 64 + lane] = v[0];
    __syncthreads();
    if (tid < 64) { float s = 0.f;
#pragma unroll
        for (int w8 = 0; w8 < 8; ++w8) s += part[w8 * 64 + tid];
        part[tid] = s; }
    __syncthreads();
    if (tid < 32) { const float mean = part[tid] * (1.0f / 1024.0f); const float var = part[32 + tid] * (1.0f / 1024.0f) - mean * mean; stat[tid] = mean; stat[32 + tid] = __builtin_amdgcn_rsqf(fmaxf(var, 0.f) + EPS); }
    __syncthreads();
    const f32x2 g = *(const f32x2*)(lg + c0), bb = *(const f32x2*)(lb + c0);
    unsigned sgv[32];
#pragma unroll
    for (int i = 0; i < 32; ++i) sgv[i] = *(const unsigned*)(SG + (size_t)(t0 + i) * DM + HALFW + c0);
    __builtin_amdgcn_sched_barrier(0);
#pragma unroll
    for (int i = 0; i < 32; ++i) {
        const float mean = stat[i], rstd = stat[32 + i];
        const float a0 = siluf_((y0[i] - mean) * rstd * g[0] + bb[0]), a1 = siluf_((y1[i] - mean) * rstd * g[1] + bb[1]);
        const size_t off = (size_t)(t0 + i) * DM + HALFW + c0;
        const unsigned sg = sgv[i];
        *(unsigned*)(YG + off) = cvt_pk_bf16(a0 * bflo(sg), a1 * bfhi(sg));
    }
}

constexpr int N_PHASES = 26;
struct Args { const float* in[18]; float* out; unsigned char* ws; int ph_lo, ph_hi; };
template <int MASK>
__global__ void __launch_bounds__(512, 2) trunk_fwd(Args a_unused) {
    extern __shared__ __attribute__((aligned(16))) unsigned char lds_raw[];
#define SITE_BEGIN() \
    const __attribute__((address_space(4))) Args* ap = (const __attribute__((address_space(4))) Args*)__builtin_amdgcn_kernarg_segment_ptr(); asm volatile("" : "+s"(ap)); \
    Frame F; { F.tid = opaque_tid(); F.lane = F.tid & 63; F.wave = __builtin_amdgcn_readfirstlane(F.tid >> 6); int b_ = blockIdx.x, g_ = gridDim.x; asm volatile("" : "+s"(b_), "+s"(g_)); F.bid = b_; F.G = g_; } \
    F.lds = (LAS unsigned char*)lds_raw; unsigned char* ws = ap->ws; F.ctl = (unsigned*)(ws + WS_CTL); (void)ws
#define EN(k) (((MASK) >> (k)) & 1)
#define RUN(p) (lo <= (p) && (p) < hi)
#define SEAM(p) do { if ((p) + 1 < hi) xcd_barrier(bar); } while (0)
    int lo, hi; XcdBarrier bar;
    {
        const __attribute__((address_space(4))) Args* ap0 = (const __attribute__((address_space(4))) Args*)__builtin_amdgcn_kernarg_segment_ptr();
        lo = ap0->ph_lo; hi = ap0->ph_hi;
        volatile LAS unsigned* MISC = (volatile LAS unsigned*)((LAS unsigned char*)lds_raw + MISC_OFF);
        if (threadIdx.x < 64) MISC[threadIdx.x] = 0u;
        __syncthreads();
        unsigned* barw = (unsigned*)(ap0->ws + WS_CTL) + CW_BAR;
        bar.bar = barw; bar.x = 0; bar.st = nullptr;
        if (hi - lo > 1) bar = xcd_barrier_post(barw, MISC + 8);
    }
    if (EN(0) && RUN(0)) { SITE_BEGIN();
        phase_p0a(F, ap->in[1], ap->in[3], ap->in[5], ap->in[6], ap->in[7], ap->in[11], ws); SEAM(0); }
    if (EN(1) && RUN(1)) { SITE_BEGIN(); phase_p0b(F, ap->in[4], ws); SEAM(1); }
    for (int lp = 0; lp < 2; ++lp) {
        const int pb = 2 + 12 * lp;
        if (EN(2) && RUN(pb + 0)) { SITE_BEGIN(); const int l = 2 * lp;
            if (l == 0) phase_norm<false>(F, ap->in[0], ap->in[2] + l * DM, (const float*)(ws + WS_MODF) + l * 6144, (bf16_t*)(ws + WS_H));
            else phase_norm<true>(F, ws + WS_XB, ap->in[2] + l * DM, (const float*)(ws + WS_MODF) + l * 6144, (bf16_t*)(ws + WS_H));
            SEAM(pb + 0); }
        if (EN(3) && RUN(pb + 1)) { SITE_BEGIN(); const int e = lp;
            const bf16_t* WEV = (const bf16_t*)(ws + WS_WEV) + (size_t)e * EV_N * DM; const bf16_t* H = (const bf16_t*)(ws + WS_H);
            { pg8::Gemm g{H, WEV, SEQ, EV_MAIN, DM}; pg8::StaticOrder S; S.init(SEQ, EV_MAIN, F.G, F.bid);
              epi::EpiEven E{ws, (float*)(ws + WS_CTL + CTL_KMEAN_OFF) + (size_t)e * 65536, ap->in[9] + e * HD, ap->in[10] + e * HD, F.lds + SCR_OFF};
              pg8::gemm_phase(F.lds, g, S, E); }
            { pg8::Gemm g{WEV + (size_t)EV_MAIN * DM, H, HALFW, SEQ, DM}; pg8::StaticOrder S; S.init(HALFW, SEQ, F.G, F.bid);
              epi::EpiVT E{(bf16_t*)(ws + WS_VT)}; pg8::gemm_phase(F.lds, g, S, E); }
            SEAM(pb + 1); }
        if (EN(4) && RUN(pb + 2)) { SITE_BEGIN(); const int e = lp;
            phase_pool_d(F, (const bf16_t*)(ws + WS_UA), (bf16_t*)(ws + WS_D));
            float knb; { const float* kn = ap->in[10] + e * HD; float mx = fmaxf(fabsf(kn[F.lane]), fabsf(kn[64 + F.lane]));
#pragma unroll
              for (int o_ = 1; o_ < 64; o_ <<= 1) mx = fmaxf(mx, __shfl_xor(mx, o_));
              knb = mx * 11.3137085f * 1.01f; }
            phase_top3(F, (const bf16_t*)(ws + WS_Q), (const float*)(ws + WS_CTL + CTL_KMEAN_OFF) + (size_t)e * 65536, F.ctl + CW_CNT + e * 512 * 16, (unsigned*)(ws + WS_LIST), (float*)(ws + WS_PARTML), knb); SEAM(pb + 2); }
        if (EN(5) && RUN(pb + 3)) { SITE_BEGIN(); const int e = lp;
            { pg8::Gemm g{(const bf16_t*)(ws + WS_D), (const bf16_t*)(ws + WS_PWT) + (size_t)e * 4 * 65536, 4 * SEQ, HALFW, 256}; pg8::PoolOrder S{F.G, F.bid};
              epi::EpiPool E{ap->in[8] + e * HALFW, (const bf16_t*)(ws + WS_SG), (bf16_t*)(ws + WS_H)}; pg8::gemm_phase(F.lds, g, S, E); }
            LAS int* offt = (LAS int*)(F.lds + 158720);
            const unsigned* cnt = F.ctl + CW_CNT + e * 512 * 16;
            __syncthreads();
            if (F.wave == 0) {
                int loc[8]; int s = 0;
#pragma unroll
                for (int i = 0; i < 8; ++i) { const int idx = F.lane * 8 + i; const int c = (int)__hip_atomic_load(cnt + idx * 16, __ATOMIC_RELAXED, __HIP_MEMORY_SCOPE_AGENT); loc[i] = ((idx & 63) < 63) ? ((c + 255) >> 8) : 0; s += loc[i]; }
                int inc = s;
#pragma unroll
                for (int off = 1; off < 64; off <<= 1) { const int v = __shfl_up(inc, off); if (F.lane >= off) inc += v; }
                int ex = inc - s;
#pragma unroll
                for (int i = 0; i < 8; ++i) { offt[F.lane * 8 + i] = ex; ex += loc[i]; }
                if (F.lane == 63) offt[512] = inc;
            }
            __syncthreads();
            const int total = offt[512];
            for (int u = F.bid; u < total; u += F.G) {
                int lo_ = 0, hi_ = 511;
                while (lo_ < hi_) { const int mid = (lo_ + hi_ + 1) >> 1; if (offt[mid] <= u) lo_ = mid; else hi_ = mid - 1; }
                const int idx = lo_, c = u - offt[idx];
                att::moba_sel_unit(F.lds, idx >> 6, idx & 63, c, (int)__hip_atomic_load(cnt + idx * 16, __ATOMIC_RELAXED, __HIP_MEMORY_SCOPE_AGENT), (const unsigned*)(ws + WS_LIST), (const bf16_t*)(ws + WS_Q), (const bf16_t*)(ws + WS_K), (const bf16_t*)(ws + WS_VT),
                                   (bf16_t*)(ws + WS_PARTO), (float*)(ws + WS_PARTML));
            }
            SEAM(pb + 3); }
        if (EN(6) && RUN(pb + 4)) { SITE_BEGIN();
            for (int u = F.bid; u < 512; u += F.G) att::moba_own_unit(F.lds, u & 7, u >> 3, (const bf16_t*)(ws + WS_Q), (const bf16_t*)(ws + WS_K), (const bf16_t*)(ws + WS_VT),
                                                                     (const bf16_t*)(ws + WS_PARTO), (const float*)(ws + WS_PARTML), (const bf16_t*)(ws + WS_SG), (bf16_t*)(ws + WS_H));
            SEAM(pb + 4); }
        if (EN(7) && RUN(pb + 5)) { SITE_BEGIN(); const int l = 2 * lp;
            pg8::Gemm g{(const bf16_t*)(ws + WS_H), (const bf16_t*)(ws + WS_WOUT) + (size_t)l * DM * DM, SEQ, DM, DM}; pg8::StaticOrder S; S.init(SEQ, DM, F.G, F.bid);
            if (l == 0) { epi::EpiOut<false, true> E{ap->in[0], ws + WS_XB, (const float*)(ws + WS_MODF) + l * 6144 + 2 * DM, F.lds + SCR_OFF}; pg8::gemm_phase(F.lds, g, S, E); }
            else { epi::EpiOut<true, true> E{ws + WS_XB, ws + WS_XB, (const float*)(ws + WS_MODF) + l * 6144 + 2 * DM, F.lds + SCR_OFF}; pg8::gemm_phase(F.lds, g, S, E); }
            SEAM(pb + 5); }
        if (EN(8) && RUN(pb + 6)) { SITE_BEGIN(); const int l = 2 * lp + 1;
            phase_norm<true>(F, ws + WS_XB, ap->in[2] + l * DM, (const float*)(ws + WS_MODF) + l * 6144, (bf16_t*)(ws + WS_H)); SEAM(pb + 6); }
        if (EN(9) && RUN(pb + 7)) { SITE_BEGIN(); const int o = lp;
            const bf16_t* WOD = (const bf16_t*)(ws + WS_WOD) + (size_t)o * OD_N * DM; const bf16_t* H = (const bf16_t*)(ws + WS_H);
            { pg8::Gemm g{H, WOD, SEQ, OD_MAIN, DM}; pg8::StaticOrder S; S.init(SEQ, OD_MAIN, F.G, F.bid);
              epi::EpiOdd E{ws, F.ctl + CW_KIMAX + o * 8, ap->in[12] + o * HD, ap->in[13] + o * HD, F.lds + SCR_OFF};
              pg8::gemm_phase(F.lds, g, S, E); }
            { pg8::Gemm g{WOD + (size_t)OD_MAIN * DM, H, HALFW, SEQ, DM}; pg8::StaticOrder S; S.init(HALFW, SEQ, F.G, F.bid);
              epi::EpiVT E{(bf16_t*)(ws + WS_VT)}; pg8::gemm_phase(F.lds, g, S, E); }
            SEAM(pb + 7); }
        if (EN(10) && RUN(pb + 8)) {
            { SITE_BEGIN(); const int o = lp;
              for (int tile = F.bid; tile < 512; tile += F.G)
                  conv_unit(F.lds, tile, (const bf16_t*)(ws + WS_U), ap->in[14] + (size_t)o * 31 * HALFW, ap->in[15] + o * HALFW, ap->in[16] + o * HALFW, ap->in[17] + o * HALFW, (const bf16_t*)(ws + WS_SG), (bf16_t*)(ws + WS_H)); }
            { SITE_BEGIN(); const int o = lp;
              const unsigned* kimax = F.ctl + CW_KIMAX + o * 8;
              float kb2 = 0.f;
#pragma unroll
              for (int i = 0; i < 8; ++i) kb2 += __uint_as_float(__hip_atomic_load(kimax + i, __ATOMIC_RELAXED, __HIP_MEMORY_SCOPE_AGENT));
              const float kib = sqrtf(kb2);
              __syncthreads();
              for (int p = F.bid; p < 512; p += F.G) { const int qt = p < 256 ? p : 767 - p;
                  dsa::select_unit(F.lds, qt, (const bf16_t*)(ws + WS_QI), (const float*)(ws + WS_WI), (const bf16_t*)(ws + WS_KI), kib, (unsigned short*)(ws + WS_MASK)); } }
            SEAM(pb + 8); }
        if (EN(11) && RUN(pb + 9)) { SITE_BEGIN();
            float knb; { const float* kn = ap->in[13] + lp * HD; float mx = fmaxf(fabsf(kn[F.lane]), fabsf(kn[64 + F.lane]));
#pragma unroll
              for (int o_ = 1; o_ < 64; o_ <<= 1) mx = fmaxf(mx, __shfl_xor(mx, o_));
              knb = mx * 11.3137085f * 1.01f; }
            LAS int* uq = (LAS int*)(F.lds + att::ATT_SCR + 256);
            for (;;) {
                __syncthreads();
                if (F.tid == 0) uq[0] = (int)atomicAdd(F.ctl + CW_DQ + lp, 1u);
                __syncthreads();
                const int u = uq[0]; if (u >= 608) break;
                int h, qb, j0, j1, slot = -1;
                if (u < 64) { h = 6; qb = 63 - u; j0 = 0; j1 = 4 * qb + 4; }
                else if (u < 208) { int v = u - 64, k, c;
                    if (v < 64) { k = v >> 2; c = v & 3; } else if (v < 112) { v -= 64; k = 16 + v / 3; c = v % 3; } else { v -= 112; k = 32 + (v >> 1); c = v & 1; }
                    h = 7; qb = 63 - k; const int T = 4 * qb + 4; j1 = T - 64 * c; j0 = j1 - 64 < 0 ? 0 : j1 - 64; slot = 4 * k + c; }
                else if (u < 224) { h = 7; qb = 15 - (u - 208); j0 = 0; j1 = 4 * qb + 4; }
                else { const int k = u - 224; h = 5 - (k >> 6); qb = 63 - (k & 63); j0 = 0; j1 = 4 * qb + 4; }
                att::dsa_unit(F.lds, h, qb, j0, j1, slot, (const bf16_t*)(ws + WS_Q), (const bf16_t*)(ws + WS_K), (const bf16_t*)(ws + WS_VT), (const unsigned short*)(ws + WS_MASK), (const bf16_t*)(ws + WS_SG), (bf16_t*)(ws + WS_H),
                              (bf16_t*)(ws + WS_PARTO), (float*)(ws + WS_PARTML), knb);
            }
            SEAM(pb + 9); }
        if (EN(13) && RUN(pb + 10)) { SITE_BEGIN();
            att::dsa_merge(F.bid, F.G, F.tid, (const bf16_t*)(ws + WS_PARTO), (const float*)(ws + WS_PARTML), (const bf16_t*)(ws + WS_SG), (bf16_t*)(ws + WS_H));
            SEAM(pb + 10); }
        if (EN(12) && RUN(pb + 11)) { SITE_BEGIN(); const int l = 2 * lp + 1;
            pg8::Gemm g{(const bf16_t*)(ws + WS_H), (const bf16_t*)(ws + WS_WOUT) + (size_t)l * DM * DM, SEQ, DM, DM}; pg8::StaticOrder S; S.init(SEQ, DM, F.G, F.bid);
            if (l == 3) { epi::EpiOut<true, false> E{ws + WS_XB, ap->out, (const float*)(ws + WS_MODF) + l * 6144 + 2 * DM, F.lds + SCR_OFF}; pg8::gemm_phase(F.lds, g, S, E); }
            else { epi::EpiOut<true, true> E{ws + WS_XB, ws + WS_XB, (const float*)(ws + WS_MODF) + l * 6144 + 2 * DM, F.lds + SCR_OFF}; pg8::gemm_phase(F.lds, g, S, E); }
            SEAM(pb + 11); }
    }
#undef RUN
#undef SEAM
#undef EN
#undef SITE_BEGIN
}

#ifndef N_LAUNCH_MODE
#define N_LAUNCH_MODE 1
#endif
template <int MASK> static void launch_one(int grid, const Args& a, hipStream_t stream) {
    static bool attr = false;
    if (!attr) { attr = true; if (hipFuncSetAttribute((const void*)trunk_fwd<MASK>, hipFuncAttributeMaxDynamicSharedMemorySize, LDS_BYTES) != hipSuccess) fprintf(stderr, "kernel_launch: hipFuncSetAttribute failed\n"); }
    hipLaunchKernelGGL(trunk_fwd<MASK>, dim3(grid), dim3(512), LDS_BYTES, stream, a);
}
extern "C" void kernel_launch(void* const* d_in, const int* in_sizes, int n_in, void* d_out, int out_size, void* d_ws, size_t ws_size, hipStream_t stream) {
    static int grid = 0;
    if (grid == 0) {
        if (n_in != 18 || in_sizes[0] != SEQ * DM || out_size != SEQ * DM || ws_size < WS_END) { fprintf(stderr, "kernel_launch: unexpected shapes (n_in %d, ws %zu)\n", n_in, ws_size); grid = -1; return; }
        int dev = 0, cus = 0;
        if (hipGetDevice(&dev) != hipSuccess || hipDeviceGetAttribute(&cus, hipDeviceAttributeMultiprocessorCount, dev) != hipSuccess) { grid = -1; return; }
        grid = cus;
    }
    if (grid < 0) return;
    if (hipMemsetAsync((char*)d_ws + WS_CTL, 0, CTL_ZERO_BYTES, stream) != hipSuccess) return;
    Args a{};
    for (int i = 0; i < 18; ++i) a.in[i] = (const float*)d_in[i];
    a.out = (float*)d_out; a.ws = (unsigned char*)d_ws;
#if N_LAUNCH_MODE == 1
    a.ph_lo = 0; a.ph_hi = N_PHASES;
    launch_one<0x3fff>(grid, a, stream);
#else
    for (int p = 0; p < N_PHASES; ++p) {
        a.ph_lo = p; a.ph_hi = p + 1;
        const int r_ = p < 2 ? 0 : (p - 2) % 12; const int site = p < 2 ? p : (r_ < 10 ? 2 + r_ : (r_ == 10 ? 13 : 12));
        switch (site) {
            case 0: launch_one<1 << 0>(grid, a, stream); break; case 1: launch_one<1 << 1>(grid, a, stream); break; case 2: launch_one<1 << 2>(grid, a, stream); break;
            case 3: launch_one<1 << 3>(grid, a, stream); break; case 4: launch_one<1 << 4>(grid, a, stream); break; case 5: launch_one<1 << 5>(grid, a, stream); break;
            case 6: launch_one<1 << 6>(grid, a, stream); break; case 7: launch_one<1 << 7>(grid, a, stream); break; case 8: launch_one<1 << 8>(grid, a, stream); break;
            case 9: launch_one<1 << 9>(grid, a, stream); break; case 10: launch_one<1 << 10>(grid, a, stream); break; case 11: launch_one<1 << 11>(grid, a, stream); break;
            case 12: launch_one<1 << 12>(grid, a, stream); break;
            default: launch_one<1 << 13>(grid, a, stream); break;
        }
    }
#endif
}
```
